# Optimizing an MI355X kernel written in HIP

```python
import math
import jax, jax.numpy as jnp
from jax import lax
import numpy as np

D_MODEL = 2048
BATCH = 4
SEQ = 2048
DEPTH = 2

HEAD_DIM = 64
GROUP_WIDTH = D_MODEL // 4
CONV_WIDTH = GROUP_WIDTH
CONV_K = 3
SWA_HEADS = GROUP_WIDTH // HEAD_DIM
SWA_KV_HEADS = max(1, SWA_HEADS // 4)
SWA_GROUP = SWA_HEADS // SWA_KV_HEADS
SWA_WIDTH = SWA_HEADS * HEAD_DIM
SWA_KV_WIDTH = SWA_KV_HEADS * HEAD_DIM
SWA_WINDOW = 128
DIL_HEADS = GROUP_WIDTH // HEAD_DIM
DIL_WIDTH = DIL_HEADS * HEAD_DIM
DIL_PAIRS = ((128, 1), (512, 4), (2048, 16))
RWKV_HEADS = GROUP_WIDTH // HEAD_DIM
RWKV_WIDTH = RWKV_HEADS * HEAD_DIM
DECAY_LORA = 64
ICLR_LORA = 64
VRES_LORA = 32
GATE_LORA = 128
RWKV_IN_WIDTH = 3 * RWKV_WIDTH + DECAY_LORA + ICLR_LORA + GATE_LORA
MIX_WIDTH = CONV_WIDTH + SWA_WIDTH + DIL_WIDTH + RWKV_WIDTH
IN_SPLITS = (CONV_WIDTH, CONV_WIDTH, CONV_WIDTH,
             SWA_WIDTH, SWA_KV_WIDTH, SWA_KV_WIDTH,
             DIL_WIDTH, DIL_WIDTH, DIL_WIDTH,
             RWKV_IN_WIDTH)
IN_WIDTH = sum(IN_SPLITS)
D_FF = 4 * D_MODEL
BLK = 128
NUM_BUCKETS = 32
BUCKET_MAX_DIST = 128
N_ATTN_HEADS = SWA_HEADS + DIL_HEADS
RMS_EPS = 1e-6
LN_X_EPS = 64e-5
NEG = -1e30

kernel_name = 'hybrid_parallel_heads_block'


def split_cols(t, sizes):
    out, start = [], 0
    for s in sizes:
        out.append(t[..., start:start + s])
        start += s
    return out


def rms_norm(x, g, eps=RMS_EPS):
    xf = x.astype(jnp.float32)
    y = xf * lax.rsqrt(jnp.mean(xf * xf, axis=-1, keepdims=True) + eps)
    return y.astype(x.dtype) * g


def t5_bucket(dist):
    dist = jnp.maximum(dist, 0)
    max_exact = NUM_BUCKETS // 2
    scaled = jnp.log(jnp.maximum(dist, 1).astype(jnp.float32) / max_exact) / math.log(BUCKET_MAX_DIST / max_exact)
    large = max_exact + (scaled * (NUM_BUCKETS - max_exact)).astype(jnp.int32)
    large = jnp.minimum(large, NUM_BUCKETS - 1)
    return jnp.where(dist < max_exact, dist, large)


def block_rel_bias(table_cols, stride):
    dist = BLK + jnp.arange(BLK)[:, None] - jnp.arange(2 * BLK)[None, :]
    bucket = t5_bucket(dist * stride)
    return jnp.transpose(table_cols[bucket].astype(jnp.float32), (2, 0, 1))


def banded_attention(q, k, v, bias, max_dist, sink=None):
    n, hk, g, seq, dh = q.shape
    nb = -(-seq // BLK)
    pad = nb * BLK - seq
    qb = jnp.pad(q, ((0, 0), (0, 0), (0, 0), (0, pad), (0, 0))).reshape(n, hk, g, nb, BLK, dh)

    def windows(t):
        tb = jnp.pad(t, ((0, 0), (0, 0), (BLK, pad), (0, 0))).reshape(n, hk, nb + 1, BLK, dh)
        return jnp.concatenate([tb[:, :, :-1], tb[:, :, 1:]], axis=3)

    kw, vw = windows(k), windows(v)
    s = jnp.einsum('nhgiqd,nhikd->nhgiqk', qb, kw, preferred_element_type=jnp.float32) * (dh ** -0.5)
    s = s + bias[None, :, :, None]
    dist = BLK + jnp.arange(BLK)[:, None] - jnp.arange(2 * BLK)[None, :]
    kpos = (jnp.arange(nb)[:, None] - 1) * BLK + jnp.arange(2 * BLK)[None, :]
    valid = ((dist >= 0) & (dist <= max_dist))[None] & (kpos >= 0)[:, None, :]
    s = jnp.where(valid, s, NEG)
    m = jnp.max(s, axis=-1, keepdims=True)
    if sink is not None:
        sk = sink.astype(jnp.float32)[None, :, :, None, None, None]
        m = jnp.maximum(m, sk)
    p = jnp.exp(s - m)
    den = jnp.sum(p, axis=-1, keepdims=True)
    if sink is not None:
        den = den + jnp.exp(sk - m)
    o = jnp.einsum('nhgiqk,nhikd->nhgiqd', p, vw.astype(jnp.float32)) / den
    lse = (m + jnp.log(den))[..., 0]
    o = o.reshape(n, hk, g, nb * BLK, dh)[:, :, :, :seq].astype(q.dtype)
    lse = lse.reshape(n, hk, g, nb * BLK)[..., :seq]
    return o, lse


def dilate(t, r):
    b, h, s, d = t.shape
    return t.reshape(b, h, s // r, r, d).transpose(0, 3, 1, 2, 4).reshape(b * r, h, s // r, d)


def undilate(t, r):
    br, h, l, d = t.shape
    return t.reshape(br // r, r, h, l, d).transpose(0, 2, 3, 1, 4).reshape(br // r, h, l * r, d)


def short_conv_mixer(gate_b, gate_c, u, conv_w):
    z = gate_c * u
    z = lax.conv_general_dilated(z, conv_w[:, None, :], (1,), [(CONV_K - 1, 0)],
                                 dimension_numbers=('NWC', 'WIO', 'NWC'),
                                 feature_group_count=CONV_WIDTH)
    return gate_b * z


def swa_mixer(q, k, v, q_gain, k_gain, sink, bias):
    bsz, seq, _ = q.shape
    q = rms_norm(q.reshape(bsz, seq, SWA_HEADS, HEAD_DIM), q_gain)
    k = rms_norm(k.reshape(bsz, seq, SWA_KV_HEADS, HEAD_DIM), k_gain)
    v = v.reshape(bsz, seq, SWA_KV_HEADS, HEAD_DIM)
    q = q.transpose(0, 2, 1, 3).reshape(bsz, SWA_KV_HEADS, SWA_GROUP, seq, HEAD_DIM)
    o, _ = banded_attention(q, k.transpose(0, 2, 1, 3), v.transpose(0, 2, 1, 3), bias,
                            SWA_WINDOW - 1, sink.reshape(SWA_KV_HEADS, SWA_GROUP))
    return o.reshape(bsz, SWA_HEADS, seq, HEAD_DIM).transpose(0, 2, 1, 3).reshape(bsz, seq, SWA_WIDTH)


def dilated_mixer(q, k, v, q_gain, k_gain, biases):
    bsz, seq, _ = q.shape
    q = rms_norm(q.reshape(bsz, seq, DIL_HEADS, HEAD_DIM), q_gain).transpose(0, 2, 1, 3)
    k = rms_norm(k.reshape(bsz, seq, DIL_HEADS, HEAD_DIM), k_gain).transpose(0, 2, 1, 3)
    v = v.reshape(bsz, seq, DIL_HEADS, HEAD_DIM).transpose(0, 2, 1, 3)
    outs, lses = [], []
    for (window, r), bias in zip(DIL_PAIRS, biases):
        o, lse = banded_attention(dilate(q, r)[:, :, None], dilate(k, r), dilate(v, r), bias, window // r)
        outs.append(undilate(o[:, :, 0], r))
        lses.append(undilate(lse[:, :, 0, :, None], r))
    wts = jax.nn.softmax(jnp.stack(lses), axis=0)
    o = jnp.sum(wts * jnp.stack(outs).astype(jnp.float32), axis=0).astype(q.dtype)
    return o.transpose(0, 2, 1, 3).reshape(bsz, seq, DIL_WIDTH)


def wkv7_scan(r, w, k, v, a, b):
    bsz, seq, nh, n = r.shape

    def step(state, inp):
        r_t, w_t, k_t, v_t, a_t, b_t = inp
        sa = jnp.einsum('bhvk,bhk->bhv', state, a_t)
        state = (state * w_t[:, :, None, :] + sa[..., None] * b_t[:, :, None, :]
                 + v_t[..., None] * k_t[:, :, None, :])
        return state, jnp.einsum('bhvk,bhk->bhv', state, r_t)

    xs = tuple(jnp.swapaxes(t, 0, 1) for t in (r, w, k, v, a, b))
    state0 = jnp.zeros((bsz, nh, n, n), jnp.float32)
    _, y = lax.scan(step, state0, xs)
    return jnp.swapaxes(y, 0, 1)


def rwkv7_mixer(p, mu, w0, w2, a0, a2, g2, k_k, k_a, r_k, ln_g, ln_b, v_first, vres):
    bsz, seq, _ = p.shape
    prev = jnp.pad(p, ((0, 0), (1, 0), (0, 0)))[:, :seq]
    p = p + (prev - p) * mu
    r, k, v, wd, ad, gd = split_cols(p, (RWKV_WIDTH, RWKV_WIDTH, RWKV_WIDTH, DECAY_LORA, ICLR_LORA, GATE_LORA))
    logw = -jax.nn.softplus(-(w0 + jnp.tanh(wd) @ w2)) - 0.5
    decay = jnp.exp(-jnp.exp(logw.astype(jnp.float32)))
    a = jax.nn.sigmoid(a0 + ad @ a2)
    g = jax.nn.sigmoid(gd) @ g2
    if vres is None:
        v_first = v
    else:
        v0, v1, v2 = vres
        v = v + (v_first - v) * jax.nn.sigmoid(v0 + (v @ v1) @ v2)

    def heads(t):
        return t.reshape(bsz, seq, RWKV_HEADS, HEAD_DIM).astype(jnp.float32)

    kk = heads(k * k_k)
    kk = kk * lax.rsqrt(jnp.maximum(jnp.sum(kk * kk, axis=-1, keepdims=True), 1e-24))
    k = k * (1 + (a - 1) * k_a)
    rh, kh, vh, ah, wh = heads(r), heads(k), heads(v), heads(a), heads(decay)
    y = wkv7_scan(rh, wh, kh, vh, -kk, kk * ah)
    mean = jnp.mean(y, axis=-1, keepdims=True)
    var = jnp.mean(jnp.square(y - mean), axis=-1, keepdims=True)
    y = (y - mean) * lax.rsqrt(var + LN_X_EPS)
    y = y.reshape(bsz, seq, RWKV_WIDTH) * ln_g + ln_b
    bonus = (jnp.sum(rh * kh * r_k.astype(jnp.float32), axis=-1, keepdims=True) * vh).reshape(bsz, seq, RWKV_WIDTH)
    y = (y + bonus).astype(p.dtype) * g
    return y, v_first


def setup_inputs(seed: int = 0) -> dict:
    key = jax.random.key(seed)
    ks = iter(jax.random.split(key, 40))

    def nrm(shape, scale):
        return jax.random.normal(next(ks), shape, jnp.float32) * scale

    def unif(shape, lo, hi):
        return jax.random.uniform(next(ks), shape, jnp.float32, minval=lo, maxval=hi)

    L, W = DEPTH, RWKV_WIDTH
    return {
        'x': nrm((BATCH, SEQ, D_MODEL), 1.0),
        'norm_mix': 1.0 + nrm((L, D_MODEL), 0.02),
        'w_in': nrm((L, D_MODEL, IN_WIDTH), D_MODEL ** -0.5),
        'conv_w': nrm((L, CONV_K, CONV_WIDTH), CONV_K ** -0.5),
        'swa_q_norm': 1.0 + nrm((L, HEAD_DIM), 0.02),
        'swa_k_norm': 1.0 + nrm((L, HEAD_DIM), 0.02),
        'swa_sink': nrm((L, SWA_HEADS), 0.5),
        'dil_q_norm': 1.0 + nrm((L, HEAD_DIM), 0.02),
        'dil_k_norm': 1.0 + nrm((L, HEAD_DIM), 0.02),
        'rwkv_mu': unif((L, RWKV_IN_WIDTH), 0.0, 1.0),
        'decay_w0': unif((L, W), -3.0, 1.0),
        'decay_w2': nrm((L, DECAY_LORA, W), 0.1),
        'iclr_a0': nrm((L, W), 0.1),
        'iclr_a2': nrm((L, ICLR_LORA, W), 0.1),
        'gate_g2': nrm((L, GATE_LORA, W), GATE_LORA ** -0.5),
        'k_k': 0.85 + nrm((L, W), 0.02),
        'k_a': 1.0 + nrm((L, W), 0.02),
        'r_k': nrm((L, RWKV_HEADS, HEAD_DIM), 0.1),
        'ln_x_g': 1.0 + nrm((L, W), 0.02),
        'ln_x_b': nrm((L, W), 0.02),
        'vres_v0': nrm((L - 1, W), 0.1),
        'vres_v1': nrm((L - 1, W, VRES_LORA), W ** -0.5),
        'vres_v2': nrm((L - 1, VRES_LORA, W), 0.1),
        'w_out': nrm((L, MIX_WIDTH, D_MODEL), MIX_WIDTH ** -0.5),
        'norm_ffn': 1.0 + nrm((L, D_MODEL), 0.02),
        'w_up': nrm((L, D_MODEL, D_FF), D_MODEL ** -0.5),
        'w_down': nrm((L, D_FF, D_MODEL), D_FF ** -0.5),
        'rel_bias': nrm((NUM_BUCKETS, N_ATTN_HEADS), 0.3),
    }


def reference(x, norm_mix, w_in, conv_w, swa_q_norm, swa_k_norm, swa_sink, dil_q_norm, dil_k_norm,
              rwkv_mu, decay_w0, decay_w2, iclr_a0, iclr_a2, gate_g2, k_k, k_a, r_k, ln_x_g, ln_x_b,
              vres_v0, vres_v1, vres_v2, w_out, norm_ffn, w_up, w_down, rel_bias):
    swa_bias = block_rel_bias(rel_bias[:, :SWA_HEADS], 1).reshape(SWA_KV_HEADS, SWA_GROUP, BLK, 2 * BLK)
    dil_biases = [block_rel_bias(rel_bias[:, SWA_HEADS:], r)[:, None] for _, r in DIL_PAIRS]
    v_first = None
    for layer in range(DEPTH):
        h = rms_norm(x, norm_mix[layer])
        proj = h @ w_in[layer]
        c_b, c_c, c_u, s_q, s_k, s_v, d_q, d_k, d_v, rw = split_cols(proj, IN_SPLITS)
        y_conv = short_conv_mixer(c_b, c_c, c_u, conv_w[layer])
        y_swa = swa_mixer(s_q, s_k, s_v, swa_q_norm[layer], swa_k_norm[layer], swa_sink[layer], swa_bias)
        y_dil = dilated_mixer(d_q, d_k, d_v, dil_q_norm[layer], dil_k_norm[layer], dil_biases)
        vres = None if layer == 0 else (vres_v0[layer - 1], vres_v1[layer - 1], vres_v2[layer - 1])
        y_rwkv, v_first = rwkv7_mixer(rw, rwkv_mu[layer], decay_w0[layer], decay_w2[layer], iclr_a0[layer],
                                      iclr_a2[layer], gate_g2[layer], k_k[layer], k_a[layer], r_k[layer],
                                      ln_x_g[layer], ln_x_b[layer], v_first, vres)
        x = x + jnp.concatenate([y_conv, y_swa, y_dil, y_rwkv], axis=-1) @ w_out[layer]
        h = rms_norm(x, norm_ffn[layer])
        x = x + jnp.square(jax.nn.relu(h @ w_up[layer])) @ w_down[layer]
    return x
```

```cpp
#include <hip/hip_runtime.h>
#include <cstdio>
#include <cstdint>
#include <cmath>
#ifndef REP_P1
#define REP_P1 1
#define REP_P2 1
#define REP_P3 1
#define REP_P4 1
#endif

constexpr int D_MODEL = 2048, BATCH = 4, SEQ = 2048, DEPTH = 2, HD = 64;
constexpr int M_TOK = BATCH * SEQ;
constexpr int IN_W = 5632, D_FF = 8192;
constexpr int RW_W = 1792;
constexpr int OFF_CB = 0, OFF_CC = 512, OFF_CU = 1024, OFF_SQ = 1536, OFF_SK = 2048, OFF_SV = 2176,
              OFF_DQ = 2304, OFF_DK = 2816, OFF_DV = 3328, OFF_RW = 3840;
constexpr float RMS_EPS = 1e-6f, LN_X_EPS = 64e-5f, NEGF = -1e30f;

typedef unsigned short bf16;
#define GAS __attribute__((address_space(1)))
#define LAS __attribute__((address_space(3)))
typedef unsigned v4u __attribute__((ext_vector_type(4)));
typedef float f32x4 __attribute__((ext_vector_type(4)));
typedef float f32x2 __attribute__((ext_vector_type(2)));
__device__ __forceinline__ unsigned f2bf(float f) { unsigned u = __builtin_bit_cast(unsigned, f); return (u + 0x7fffu + ((u >> 16) & 1u)) >> 16; }
typedef __bf16 bf16n2 __attribute__((ext_vector_type(2)));
__device__ __forceinline__ unsigned pk2(float lo, float hi) { const f32x2 v = {lo, hi}; return __builtin_bit_cast(unsigned, __builtin_convertvector(v, bf16n2)); }
__device__ __forceinline__ float bf2f(unsigned short b) { return __builtin_bit_cast(float, (unsigned)b << 16); }
__device__ __forceinline__ float ldv(const float* p) { return *p; }
__device__ __forceinline__ float ldv(const bf16* p) { return bf2f(*p); }
__device__ __forceinline__ void stv(float* p, float v) { *p = v; }
__device__ __forceinline__ void stv(bf16* p, float v) { *p = (bf16)f2bf(v); }

__device__ __forceinline__ float wave_sum(float v) {
#pragma unroll
    for (int o = 1; o < 64; o <<= 1) v += __shfl_xor(v, o);
    return v;
}
__device__ __forceinline__ float sigmoidf_(float x) { return 1.f / (1.f + expf(-x)); }

__device__ __forceinline__ int t5_bucket(int dist) {
    if (dist < 0) dist = 0;
    if (dist < 16) return dist;
    float scaled = logf((float)dist / 16.f) / logf(8.f);
    int large = 16 + (int)(scaled * 16.f);
    return large < 31 ? large : 31;
}

namespace pg8 {
#define PG8_LAS __attribute__((address_space(3)))
typedef unsigned short bf16_t;
typedef short bf16x8 __attribute__((ext_vector_type(8)));
typedef float f32x4 __attribute__((ext_vector_type(4)));
typedef unsigned u32x4 __attribute__((ext_vector_type(4)));
constexpr int BM = 256, BK = 64, HALF = 128, HTB = HALF * BK * 2  , STAGE_BYTES = 8 * HTB, NXCD = 8, WGM = 8;

__host__ __device__ __forceinline__ int lds_byte(int r, int c) { const int st = (r >> 4) * 2 + (c >> 5), rr = r & 15, cc = c & 31, ob = rr * 64 + cc * 2; return st * 1024 + (ob ^ (((ob >> 9) & 1) << 5)); }
__host__ __device__ __forceinline__ void stage_rc(int b, int& R, int& C) { const int st = b / 1024, sb = b % 1024, swz = sb ^ (((sb >> 9) & 1) << 5); R = (st >> 1) * 16 + swz / 64; C = (st & 1) * 32 + (swz % 64) / 2; }
__host__ __device__ __forceinline__ int perm32(int rho) { const int n = rho >> 4, i = rho & 15; return 8 * (i >> 2) + 4 * n + (i & 3); }

struct Unit { int pm, pn; };
struct Gemm { const bf16_t* A; const bf16_t* Bt; int M, N, K; };

struct StaticOrder {
    int nM, nN, nwg, G, c;
    __host__ __device__ void init(int M, int N, int G_, int c_) { nM = M / BM; nN = N / BM; nwg = nM * nN; G = G_; c = c_; }
    __host__ __device__ bool next(int i, Unit& u) const {
        const long L = (long)i * G + c; if (L >= nwg) return false;
        int wgid = (int)L; { const int q = nwg / NXCD, r = nwg % NXCD, xcd = wgid % NXCD, off = wgid / NXCD; wgid = (xcd < r ? xcd * (q + 1) : r * (q + 1) + (xcd - r) * q) + off; }
        const int nig = WGM * nN, gid = wgid / nig, fm = gid * WGM, gsz = (nM - fm) < WGM ? (nM - fm) : WGM;
        u.pm = fm + ((wgid % nig) % gsz); u.pn = (wgid % nig) / gsz; return true;
    }
    __device__ __forceinline__ void a_ready(const Unit&) const {}
    __device__ __forceinline__ void done(const Unit&) const {}
};

__device__ __forceinline__ unsigned cvt_pk_bf16(float lo, float hi) { return ::pk2(lo, hi); }
typedef float f32x2 __attribute__((ext_vector_type(2)));

template <int ACT  , bool SCALE = true> struct EpiBf16 {
    static constexpr bool PERM = true, AFTER_DRAIN = false;
    bf16_t* O; int ldc; const float* ssp;
    __device__ __forceinline__ void operator()(const f32x4 (&acc)[2][2][4][2], const Unit& u, int wr, int wc, int fr, int fq) const {
        const int row0 = u.pm * BM + wr * 64 + fr, col0 = u.pn * BM + wc * 32 + 8 * fq;
        float rs[2][4];
#pragma unroll
        for (int ai = 0; ai < 2; ++ai)
#pragma unroll
            for (int m = 0; m < 4; ++m) { if (!SCALE) { rs[ai][m] = 1.f; continue; }
                const f32x4* sp = (const f32x4*)(ssp + (size_t)(row0 + ai * HALF + m * 16) * 32 + 8 * fq); const f32x4 a = sp[0], b = sp[1];
                float t = ((a[0] + a[1]) + (a[2] + a[3])) + ((b[0] + b[1]) + (b[2] + b[3]));
                t += __shfl_xor(t, 16); t += __shfl_xor(t, 32);
                const float r = __builtin_amdgcn_rsqf(t * (1.f / 2048.f) + 1e-6f); rs[ai][m] = (ACT == 1) ? r * r : r; }
#pragma unroll
        for (int ai = 0; ai < 2; ++ai)
#pragma unroll
            for (int m = 0; m < 4; ++m) { bf16_t* rowp = O + (size_t)(row0 + ai * HALF + m * 16) * ldc + col0;
#pragma unroll
                for (int bj = 0; bj < 2; ++bj) { f32x4 v0 = acc[ai][bj][m][0], v1 = acc[ai][bj][m][1];
                    if (ACT == 1) { v0 = __builtin_elementwise_max(v0, (f32x4){0.f, 0.f, 0.f, 0.f}); v1 = __builtin_elementwise_max(v1, (f32x4){0.f, 0.f, 0.f, 0.f}); v0 = v0 * v0; v1 = v1 * v1; }
                    if (SCALE) { v0 = v0 * rs[ai][m]; v1 = v1 * rs[ai][m]; }
                    u32x4 w; w.x = cvt_pk_bf16(v0[0], v0[1]); w.y = cvt_pk_bf16(v0[2], v0[3]); w.z = cvt_pk_bf16(v1[0], v1[1]); w.w = cvt_pk_bf16(v1[2], v1[3]);
                    *(u32x4*)(rowp + bj * HALF) = w; } }
    }
};
template <int RMODE, bool WRITEC, bool NORM, bool INSCALE> struct EpiRes {
    static constexpr bool PERM = false, AFTER_DRAIN = false;
    float* C; const float* R; int ldc; bf16_t* HN; const float* gW; float* ssp; const float* ssp_in; const float* gR;
    __device__ __forceinline__ void operator()(const f32x4 (&acc)[2][2][4][2], const Unit& u, int wr, int wc, int fr, int fq) const {
        const int row0 = u.pm * BM + wr * 64 + fr, col0 = u.pn * BM + wc * 32 + 4 * fq;
        f32x4 gv[2][2], gi[2][2];
#pragma unroll
        for (int bj = 0; bj < 2; ++bj)
#pragma unroll
            for (int n = 0; n < 2; ++n) {
                if (NORM) gv[bj][n] = *(const f32x4*)(gW + col0 + bj * HALF + n * 16);
                if (RMODE == 1) { const f32x4 t = *(const f32x4*)(gR + col0 + bj * HALF + n * 16); gi[bj][n] = (f32x4){__builtin_amdgcn_rcpf(t[0]), __builtin_amdgcn_rcpf(t[1]), __builtin_amdgcn_rcpf(t[2]), __builtin_amdgcn_rcpf(t[3])}; } }
#pragma unroll
        for (int ai = 0; ai < 2; ++ai)
#pragma unroll
            for (int m = 0; m < 4; ++m) { const int row = row0 + ai * HALF + m * 16; const size_t off = (size_t)row * ldc + col0; float ssq = 0.f; float sc2 = 1.f;
                if (INSCALE) { const f32x4* sp = (const f32x4*)(ssp_in + (size_t)row * 32 + 8 * fq); const f32x4 a = sp[0], b = sp[1];
                    float t = ((a[0] + a[1]) + (a[2] + a[3])) + ((b[0] + b[1]) + (b[2] + b[3])); t += __shfl_xor(t, 16); t += __shfl_xor(t, 32);
                    const float r = __builtin_amdgcn_rsqf(t * (1.f / 2048.f) + 1e-6f); sc2 = r * r; }
#pragma unroll
                for (int bj = 0; bj < 2; ++bj)
#pragma unroll
                    for (int n = 0; n < 2; ++n) { f32x4 rv;
                        if (RMODE == 0) rv = *(const f32x4*)(R + off + bj * HALF + n * 16);
                        else { const unsigned long long w = *(const unsigned long long*)(HN + off + bj * HALF + n * 16); const unsigned lo = (unsigned)w, hi = (unsigned)(w >> 32);
                            rv = (f32x4){__builtin_bit_cast(float, lo << 16), __builtin_bit_cast(float, lo & 0xffff0000u), __builtin_bit_cast(float, hi << 16), __builtin_bit_cast(float, hi & 0xffff0000u)} * gi[bj][n]; }
                        const f32x4 x = INSCALE ? rv + acc[ai][bj][m][n] * sc2 : rv + acc[ai][bj][m][n];
                        if (WRITEC) *(f32x4*)(C + off + bj * HALF + n * 16) = x;
                        if (NORM) { ssq += (x[0] * x[0] + x[1] * x[1]) + (x[2] * x[2] + x[3] * x[3]); const f32x4 y = x * gv[bj][n];
                            *(unsigned long long*)(HN + off + bj * HALF + n * 16) = (unsigned long long)cvt_pk_bf16(y[0], y[1]) | ((unsigned long long)cvt_pk_bf16(y[2], y[3]) << 32); } }
                if (NORM) { ssq += __shfl_xor(ssq, 16); ssq += __shfl_xor(ssq, 32); if (fq == 0) ssp[(size_t)row * 32 + u.pn * 4 + wc] = ssq; } }
    }
};
template <class Epi, class Sched, bool ALIGN_EPI = false, bool SP2 = false>
__device__ __forceinline__ void gemm_phase(PG8_LAS unsigned char* lds, const Gemm g, const Sched& S, const Epi& E) {
    int tid_o = threadIdx.x; asm volatile("" : "+v"(tid_o));
    const int tid = tid_o, wid = __builtin_amdgcn_readfirstlane(tid >> 6), lane = tid & 63, wr = wid >> 2, wc = wid & 3, fr = lane & 15, fq = lane >> 4;
    const int K = g.K, nt = K / BK;
    unsigned voffA[2], voffB[2];
#pragma unroll
    for (int i = 0; i < 2; ++i) { int R, C; stage_rc(tid * 16 + i * 8192, R, C); const int Rb = Epi::PERM ? ((R & ~31) + perm32(R & 31)) : R;
        voffA[i] = (unsigned)(R * K + C) * 2u; voffB[i] = (unsigned)(Rb * K + C) * 2u; }
    const size_t kstep = (size_t)(BK * 2);
    const size_t hstep = (size_t)HALF * K * 2;
    const size_t tstep = 2 * hstep;
    const unsigned ldsw = (unsigned)wid * 1024u;
    const int aoff = lds_byte(wr * 64 + fr, fq * 8), boff = lds_byte(wc * 32 + fr, fq * 8);
#define PG8_SA(b, h) (((b) * 2 + (h)) * HTB)
#define PG8_SB(b, h) ((4 + (b) * 2 + (h)) * HTB)
#define PG8_STAGE(bufoff, gbase, voff) do { _Pragma("unroll") for (int _i = 0; _i < 2; ++_i) \
        __builtin_amdgcn_global_load_lds((const unsigned*)((const char*)(gbase) + (voff)[_i]), (PG8_LAS unsigned*)(lds + (bufoff) + ldsw + _i * 8192), 16, 0, 0); } while (0)
#define PG8_LDA(dst, b, h) do { _Pragma("unroll") for (int m = 0; m < 4; ++m) _Pragma("unroll") for (int k = 0; k < 2; ++k) dst[m][k] = *(const PG8_LAS bf16x8*)(lds + PG8_SA(b, h) + aoff + m * 2048 + k * 1024); } while (0)
#define PG8_LDB(dst, b, h) do { _Pragma("unroll") for (int n = 0; n < 2; ++n) _Pragma("unroll") for (int k = 0; k < 2; ++k) dst[n][k] = *(const PG8_LAS bf16x8*)(lds + PG8_SB(b, h) + boff + n * 2048 + k * 1024); } while (0)
#define PG8_MMA(ai, bj, At, Bt) do { __builtin_amdgcn_s_setprio(1); _Pragma("unroll") for (int m = 0; m < 4; ++m) _Pragma("unroll") for (int n = 0; n < 2; ++n) _Pragma("unroll") for (int k = 0; k < 2; ++k) \
        acc[ai][bj][m][n] = __builtin_amdgcn_mfma_f32_16x16x32_bf16(Bt[n][k], At[m][k], acc[ai][bj][m][n], 0, 0, 0); __builtin_amdgcn_s_setprio(0); } while (0)
#define PG8_WAIT_V(n) asm volatile("s_waitcnt vmcnt(" #n ")" ::: "memory")
#define PG8_WAIT_L(n) asm volatile("s_waitcnt lgkmcnt(" #n ")" ::: "memory")
#define PG8_BAR __builtin_amdgcn_s_barrier()
#define PG8_SCHED __builtin_amdgcn_sched_barrier(0)
    Unit cur, nxt; int ui = 0;
    if (!S.next(0, cur)) return;
    f32x4 acc[2][2][4][2];
#pragma unroll
    for (int a = 0; a < 2; ++a)
#pragma unroll
        for (int b = 0; b < 2; ++b)
#pragma unroll
            for (int m = 0; m < 4; ++m)
#pragma unroll
                for (int n = 0; n < 2; ++n) acc[a][b][m][n] = (f32x4){0.f, 0.f, 0.f, 0.f};
    bf16x8 At[4][2], B0[2][2], B1[2][2];
    const char* cA = (const char*)g.A + (size_t)cur.pm * tstep; const char* cB = (const char*)g.Bt + (size_t)cur.pn * tstep;
    S.a_ready(cur);
    if constexpr (SP2) {
        PG8_STAGE(PG8_SB(0, 0), cB, voffB); PG8_STAGE(PG8_SB(0, 1), cB + hstep, voffB); PG8_STAGE(PG8_SA(0, 0), cA, voffA); PG8_STAGE(PG8_SA(0, 1), cA + hstep, voffA);
        if (wr == 1) PG8_BAR;
        PG8_WAIT_V(2); PG8_BAR;
        PG8_STAGE(PG8_SB(1, 0), cB + kstep, voffB); PG8_STAGE(PG8_SA(1, 0), cA + kstep, voffA); PG8_STAGE(PG8_SB(1, 1), cB + hstep + kstep, voffB);
        PG8_WAIT_V(6); PG8_BAR;
    } else {
        PG8_STAGE(PG8_SB(0, 0), cB, voffB); PG8_STAGE(PG8_SA(0, 0), cA, voffA); PG8_STAGE(PG8_SB(0, 1), cB + hstep, voffB); PG8_STAGE(PG8_SA(0, 1), cA + hstep, voffA);
        if (wr == 1) PG8_BAR;
        PG8_WAIT_V(4); PG8_BAR;
        PG8_STAGE(PG8_SB(1, 0), cB + kstep, voffB); PG8_STAGE(PG8_SA(1, 0), cA + kstep, voffA); PG8_STAGE(PG8_SB(1, 1), cB + hstep + kstep, voffB);
        PG8_WAIT_V(6); PG8_BAR;
    }
    for (;;) {
        const bool has_next = S.next(ui + 1, nxt);
        const char* nA = has_next ? (const char*)g.A + (size_t)nxt.pm * tstep : cA; const char* nB = has_next ? (const char*)g.Bt + (size_t)nxt.pn * tstep : cB;
        for (int t = 0; t < nt; t += 2) {
            const bool last = (t == nt - 2);
            const char* a1 = cA + (size_t)(t + 1) * kstep;
            const char* a2 = last ? nA : cA + (size_t)(t + 2) * kstep; const char* b2 = last ? nB : cB + (size_t)(t + 2) * kstep;
            const char* a3 = a2 + kstep; const char* b3 = b2 + kstep;
            if (last && has_next) S.a_ready(nxt);
            if constexpr (SP2) {
            PG8_LDB(B0, 0, 0); PG8_LDB(B1, 0, 1); PG8_SCHED; PG8_LDA(At, 0, 0); PG8_STAGE(PG8_SA(1, 1), a1 + hstep, voffA);
            PG8_WAIT_V(8); PG8_WAIT_L(0); PG8_BAR; PG8_MMA(0, 0, At, B0); PG8_MMA(0, 1, At, B1); PG8_BAR; PG8_SCHED;
            PG8_LDA(At, 0, 1); PG8_STAGE(PG8_SB(0, 0), b2, voffB); PG8_STAGE(PG8_SB(0, 1), b2 + hstep, voffB); PG8_STAGE(PG8_SA(0, 0), a2, voffA);
            PG8_WAIT_V(8); PG8_WAIT_L(0); PG8_BAR; PG8_MMA(1, 0, At, B0); PG8_MMA(1, 1, At, B1); PG8_BAR; PG8_SCHED;
            PG8_LDB(B0, 1, 0); PG8_LDB(B1, 1, 1); PG8_SCHED; PG8_LDA(At, 1, 0); PG8_STAGE(PG8_SA(0, 1), a2 + hstep, voffA);
            PG8_WAIT_V(8); PG8_WAIT_L(0); PG8_BAR; PG8_MMA(0, 0, At, B0); PG8_MMA(0, 1, At, B1); PG8_BAR; PG8_SCHED;
            PG8_LDA(At, 1, 1); PG8_STAGE(PG8_SB(1, 0), b3, voffB); PG8_STAGE(PG8_SB(1, 1), b3 + hstep, voffB); PG8_STAGE(PG8_SA(1, 0), a3, voffA);
            PG8_WAIT_V(8); PG8_WAIT_L(0); PG8_BAR; PG8_MMA(1, 0, At, B0); PG8_MMA(1, 1, At, B1); PG8_BAR; PG8_SCHED;
            } else {
            PG8_LDB(B0, 0, 0); PG8_SCHED; PG8_LDA(At, 0, 0); PG8_STAGE(PG8_SA(1, 1), a1 + hstep, voffA);
            PG8_WAIT_L(8); PG8_BAR; PG8_WAIT_L(0); PG8_MMA(0, 0, At, B0); PG8_BAR; PG8_SCHED;
            PG8_LDB(B1, 0, 1); PG8_STAGE(PG8_SB(0, 0), b2, voffB);
            PG8_BAR; PG8_WAIT_L(0); PG8_MMA(0, 1, At, B1); PG8_BAR;
            PG8_LDA(At, 0, 1); PG8_STAGE(PG8_SA(0, 0), a2, voffA);
            PG8_BAR; PG8_WAIT_L(0); PG8_MMA(1, 0, At, B0); PG8_BAR; PG8_SCHED;
            PG8_STAGE(PG8_SB(0, 1), b2 + hstep, voffB);
            PG8_WAIT_V(6); PG8_BAR; PG8_MMA(1, 1, At, B1); PG8_BAR;
            PG8_LDB(B0, 1, 0); PG8_SCHED; PG8_LDA(At, 1, 0); PG8_STAGE(PG8_SA(0, 1), a2 + hstep, voffA);
            PG8_WAIT_L(8); PG8_BAR; PG8_WAIT_L(0); PG8_MMA(0, 0, At, B0); PG8_BAR; PG8_SCHED;
            PG8_LDB(B1, 1, 1); PG8_STAGE(PG8_SB(1, 0), b3, voffB);
            PG8_BAR; PG8_WAIT_L(0); PG8_MMA(0, 1, At, B1); PG8_BAR;
            PG8_LDA(At, 1, 1); PG8_STAGE(PG8_SA(1, 0), a3, voffA);
            PG8_BAR; PG8_WAIT_L(0); PG8_MMA(1, 0, At, B0); PG8_BAR; PG8_SCHED;
            PG8_STAGE(PG8_SB(1, 1), b3 + hstep, voffB);
            PG8_WAIT_V(6); PG8_BAR; PG8_MMA(1, 1, At, B1); PG8_BAR;
            }
        }
        if constexpr (ALIGN_EPI) { if (wr == 0) PG8_BAR; }
        if constexpr (!Epi::AFTER_DRAIN) { E(acc, cur, wr, wc, fr, fq); S.done(cur); }
        if (!has_next) break;
#pragma unroll
        for (int a = 0; a < 2; ++a)
#pragma unroll
            for (int b = 0; b < 2; ++b)
#pragma unroll
                for (int m = 0; m < 4; ++m)
#pragma unroll
                    for (int n = 0; n < 2; ++n) acc[a][b][m][n] = (f32x4){0.f, 0.f, 0.f, 0.f};
        cur = nxt; cA = nA; cB = nB; ++ui;
        if constexpr (ALIGN_EPI) { if (wr == 1) PG8_BAR; }
    }
    PG8_WAIT_V(0);
    if constexpr (!ALIGN_EPI) { if (wr == 0) PG8_BAR; }
    PG8_BAR;
    if constexpr (Epi::AFTER_DRAIN) { E.fused(acc, cur, wr, wc, fr, fq, lds, wid, lane); S.done(cur); }
#undef PG8_SA
#undef PG8_SB
#undef PG8_STAGE
#undef PG8_LDA
#undef PG8_LDB
#undef PG8_MMA
#undef PG8_WAIT_V
#undef PG8_WAIT_L
#undef PG8_BAR
#undef PG8_SCHED
}
}

typedef short bf16x8_t __attribute__((ext_vector_type(8)));
typedef short s16x4_t __attribute__((ext_vector_type(4)));
template <int CTRL> __device__ __forceinline__ float dpp_f(float x) { return __builtin_bit_cast(float, __builtin_amdgcn_mov_dpp(__builtin_bit_cast(int, x), CTRL, 0xF, 0xF, true)); }
__device__ __forceinline__ float allreduce16(float p) {
    p += dpp_f<0xB1>(p);
    p += dpp_f<0x4E>(p);
    p += dpp_f<0x141>(p);
    p += dpp_f<0x140>(p);
    return p;
}
__device__ __forceinline__ float allreduce8(float p) { p += dpp_f<0xB1>(p); p += dpp_f<0x4E>(p); p += dpp_f<0x141>(p); return p; }

constexpr int AT_K = 0, AT_V = 65536, AT_TB = 131072, AT_G = AT_TB + 6400, AT_RB = AT_G + 1024, AT_SK = AT_RB + 2048, AT_END = AT_SK + 32;
constexpr int N_ATT_UNITS = 2048;
__device__ __forceinline__ int k_off(int key, int chunk) { return key * 128 + ((chunk ^ ((key >> 1) & 7)) << 4); }
__device__ __forceinline__ int v_off(int key, int chunk) { return key * 128 + ((chunk ^ (((key >> 1) & 3) << 1)) << 4); }
__device__ __forceinline__ unsigned cvtpk(float lo, float hi) { const f32x2 v = {lo, hi}; return __builtin_bit_cast(unsigned, __builtin_convertvector(v, bf16n2)); }
struct AttU { int type, b, h, r, c, j; };
__device__ __forceinline__ AttU att_decode(int u) {
    AttU a; const int ux = u >> 8, uy = u & 255, jj = uy & 15; a.type = uy >> 6; a.b = ux >> 1; a.h = (ux & 1) * 4 + ((uy >> 4) & 3);
    if (a.type <= 1) { a.r = 1; a.c = 0; a.j = jj; } else if (a.type == 2) { a.r = 4; a.c = jj & 3; a.j = jj >> 2; } else { a.r = 16; a.c = jj; a.j = 0; }
    return a;
}
__device__ __forceinline__ void att_issue(LAS unsigned char* lds, int buf, const AttU& a, const bf16* __restrict__ PROJ, int wave, int lane) {
    const int kcol = a.type == 0 ? OFF_SK + 64 * (a.h >> 2) : OFF_DK + 64 * a.h, vcol = a.type == 0 ? OFF_SV + 64 * (a.h >> 2) : OFF_DV + 64 * a.h;
#pragma unroll
    for (int i = 0; i < 4; ++i) {
        const int key = 8 * (4 * wave + i) + (lane >> 3), cp = lane & 7;
        int li = 128 * (a.j - 1) + key; li = li < 0 ? 0 : li;
        const bf16* rowp = PROJ + ((size_t)a.b * SEQ + a.c + a.r * li) * IN_W;
        __builtin_amdgcn_global_load_lds((const unsigned*)(rowp + kcol + 8 * (cp ^ ((key >> 1) & 7))), (LAS unsigned*)(lds + AT_K + buf * 32768 + (4 * wave + i) * 1024), 16, 0, 0);
        __builtin_amdgcn_global_load_lds((const unsigned*)(rowp + vcol + 8 * (cp ^ (((key >> 1) & 3) << 1))), (LAS unsigned*)(lds + AT_V + buf * 32768 + (4 * wave + i) * 1024), 16, 0, 0);
    }
}
__device__ __forceinline__ void att_loadq(const AttU& a, const bf16* __restrict__ PROJ, int wave, int g, int cc, v4u& q0, v4u& q1) {
    const int qcol = a.type == 0 ? OFF_SQ + 64 * a.h : OFF_DQ + 64 * a.h;
    const bf16* qp = PROJ + ((size_t)a.b * SEQ + a.c + a.r * (128 * a.j + 16 * wave + cc)) * IN_W + qcol + 8 * g;
    q0 = *(const v4u*)qp; q1 = *(const v4u*)(qp + 32);
}
__device__ __forceinline__ void att_normq(LAS unsigned char* lds, const AttU& a, int g, const v4u q0, const v4u q1, bf16x8_t (&qf)[2]) {
    float qv[16]; float ss = 0.f;
#pragma unroll
    for (int e = 0; e < 4; ++e) { qv[2 * e] = __builtin_bit_cast(float, q0[e] << 16); qv[2 * e + 1] = __builtin_bit_cast(float, q0[e] & 0xffff0000u); qv[8 + 2 * e] = __builtin_bit_cast(float, q1[e] << 16); qv[8 + 2 * e + 1] = __builtin_bit_cast(float, q1[e] & 0xffff0000u); }
#pragma unroll
    for (int e = 0; e < 16; ++e) ss += qv[e] * qv[e];
    ss += __shfl_xor(ss, 16); ss += __shfl_xor(ss, 32);
    const float rs = rsqrtf(ss * (1.f / 64.f) + RMS_EPS) * 0.125f;
    const LAS float* qg = (const LAS float*)(lds + AT_G) + (a.type == 0 ? 0 : 128);
    const f32x4 ga = *(const LAS f32x4*)(qg + 8 * g), gb = *(const LAS f32x4*)(qg + 8 * g + 4), gc = *(const LAS f32x4*)(qg + 32 + 8 * g), gd = *(const LAS f32x4*)(qg + 32 + 8 * g + 4);
    v4u x, y;
    x.x = cvtpk(qv[0] * rs * ga.x, qv[1] * rs * ga.y); x.y = cvtpk(qv[2] * rs * ga.z, qv[3] * rs * ga.w); x.z = cvtpk(qv[4] * rs * gb.x, qv[5] * rs * gb.y); x.w = cvtpk(qv[6] * rs * gb.z, qv[7] * rs * gb.w);
    y.x = cvtpk(qv[8] * rs * gc.x, qv[9] * rs * gc.y); y.y = cvtpk(qv[10] * rs * gc.z, qv[11] * rs * gc.w); y.z = cvtpk(qv[12] * rs * gd.x, qv[13] * rs * gd.y); y.w = cvtpk(qv[14] * rs * gd.z, qv[15] * rs * gd.w);
    qf[0] = __builtin_bit_cast(bf16x8_t, x); qf[1] = __builtin_bit_cast(bf16x8_t, y);
}
#define ATT_LBAR asm volatile("s_waitcnt lgkmcnt(0)\n\ts_barrier" ::: "memory")
__device__ __forceinline__ void attn_wg(LAS unsigned char* lds, int v0, int vstride, bool xmap, const bf16* __restrict__ PROJ, const float* __restrict__ qg_swa, const float* __restrict__ kg_swa, const float* __restrict__ sink_swa,
                                        const float* __restrict__ qg_dil, const float* __restrict__ kg_dil, const float* __restrict__ rel_bias, bf16* __restrict__ MIX, bf16* __restrict__ DILO, float* __restrict__ DILL, int tid) {
    if (v0 >= N_ATT_UNITS) return;
    const int wave = __builtin_amdgcn_readfirstlane(tid >> 6), lane = tid & 63, g = lane >> 4, cc = lane & 15;
    if (tid < 256) { const int w = tid >> 6, e = tid & 63; ((LAS float*)(lds + AT_G))[tid] = (w == 0 ? qg_swa : w == 1 ? kg_swa : w == 2 ? qg_dil : kg_dil)[e]; }
    ((LAS float*)(lds + AT_RB))[tid] = rel_bias[tid];
    if (tid < 8) ((LAS float*)(lds + AT_SK))[tid] = sink_swa[tid];
    AttU a = att_decode(xmap ? (v0 & 7) * 256 + (v0 >> 3) : v0);
    att_issue(lds, 0, a, PROJ, wave, lane);
    bf16x8_t qf[2];
    { v4u q0, q1; att_loadq(a, PROJ, wave, g, cc, q0, q1); asm volatile("s_waitcnt vmcnt(0)" ::: "memory"); ATT_LBAR; att_normq(lds, a, g, q0, q1, qf); }
    int buf = 0;
    for (int v = v0; v < N_ATT_UNITS; v += vstride, buf ^= 1) {
        const bool swa = (a.type == 0);
        const int maxd = swa ? 127 : 128, bc = swa ? a.h : 8 + a.h;
        LAS unsigned char* const KB = lds + AT_K + buf * 32768; LAS unsigned char* const VB = lds + AT_V + buf * 32768;
        {
            const int x = tid >> 1, hr = tid & 1;
            v4u kr[4];
#pragma unroll
            for (int ch = 0; ch < 4; ++ch) kr[ch] = *(const LAS v4u*)(KB + k_off(x, 4 * hr + ch));
            float kf[32]; float ss = 0.f;
#pragma unroll
            for (int ch = 0; ch < 4; ++ch)
#pragma unroll
                for (int e = 0; e < 4; ++e) { const unsigned wv = kr[ch][e]; const float lo = __builtin_bit_cast(float, wv << 16), hi = __builtin_bit_cast(float, wv & 0xffff0000u); kf[ch * 8 + 2 * e] = lo; kf[ch * 8 + 2 * e + 1] = hi; ss += lo * lo + hi * hi; }
            ss += __shfl_xor(ss, 1);
            const float rs = rsqrtf(ss * (1.f / 64.f) + RMS_EPS);
            const LAS float* kg = (const LAS float*)(lds + AT_G) + (swa ? 64 : 192);
#pragma unroll
            for (int ch = 0; ch < 4; ++ch) {
                const f32x4 g0 = *(const LAS f32x4*)(kg + 32 * hr + 8 * ch), g1 = *(const LAS f32x4*)(kg + 32 * hr + 8 * ch + 4);
                v4u o; o.x = cvtpk(kf[ch * 8 + 0] * rs * g0.x, kf[ch * 8 + 1] * rs * g0.y); o.y = cvtpk(kf[ch * 8 + 2] * rs * g0.z, kf[ch * 8 + 3] * rs * g0.w);
                o.z = cvtpk(kf[ch * 8 + 4] * rs * g1.x, kf[ch * 8 + 5] * rs * g1.y); o.w = cvtpk(kf[ch * 8 + 6] * rs * g1.z, kf[ch * 8 + 7] * rs * g1.w);
                *(LAS v4u*)(KB + k_off(x, 4 * hr + ch)) = o;
            }
            if (tid < 384) { const int dist = 255 - tid; float val = NEGF; if (dist >= 0 && dist <= maxd) val = ((const LAS float*)(lds + AT_RB))[t5_bucket(dist * a.r) * 16 + bc];
#pragma unroll
                for (int sft = 0; sft < 4; ++sft) if (tid >= sft) ((LAS float*)(lds + AT_TB))[sft * 400 + tid - sft] = val; }
        }
        ATT_LBAR;
        const int vn = v + vstride; const bool more = vn < N_ATT_UNITS;
        AttU an = a; v4u qn0 = (v4u){0u, 0u, 0u, 0u}, qn1 = qn0;
        if (more) { an = att_decode(xmap ? (vn & 7) * 256 + (vn >> 3) : vn); att_issue(lds, buf ^ 1, an, PROJ, wave, lane); att_loadq(an, PROJ, wave, g, cc, qn0, qn1); }
        const int n0 = wave & ~1;
        f32x4 sc[10];
        {
            bf16x8_t kfa[10], kfb[10];
#pragma unroll
            for (int nn = 0; nn < 10; ++nn) { const int key = 16 * (n0 + nn) + cc; kfa[nn] = *(const LAS bf16x8_t*)(KB + k_off(key, g)); kfb[nn] = *(const LAS bf16x8_t*)(KB + k_off(key, g + 4)); }
            __builtin_amdgcn_sched_barrier(0);
#pragma unroll
            for (int nn = 0; nn < 10; ++nn) {
                f32x4 acc = (f32x4){0.f, 0.f, 0.f, 0.f};
                acc = __builtin_amdgcn_mfma_f32_16x16x32_bf16(kfa[nn], qf[0], acc, 0, 0, 0);
                acc = __builtin_amdgcn_mfma_f32_16x16x32_bf16(kfb[nn], qf[1], acc, 0, 0, 0);
                sc[nn] = acc;
            }
        }
        const int ib = 4 * g - 16 * wave - cc + 127;
        const LAS float* tb = (const LAS float*)(lds + AT_TB) + (ib & 3) * 400 + (ib & ~3) + 16 * n0;
        const float sink = swa ? ((const LAS float*)(lds + AT_SK))[a.h] : NEGF;
        f32x4 bv[10];
#pragma unroll
        for (int nn = 0; nn < 10; ++nn) bv[nn] = *(const LAS f32x4*)(tb + 16 * nn);
        float m = NEGF;
#pragma unroll
        for (int nn = 0; nn < 10; ++nn) {
            const int n = n0 + nn;
#pragma unroll
            for (int i = 0; i < 4; ++i) { float sv = sc[nn][i] + bv[nn][i]; if (a.j == 0 && n < 8) sv = NEGF; sc[nn][i] = sv; m = fmaxf(m, sv); }
        }
        m = fmaxf(m, __shfl_xor(m, 16)); m = fmaxf(m, __shfl_xor(m, 32));
        m = fmaxf(m, sink);
        float l = 0.f;
#pragma unroll
        for (int nn = 0; nn < 10; ++nn)
#pragma unroll
            for (int i = 0; i < 4; ++i) { const float pv = __expf(sc[nn][i] - m); sc[nn][i] = pv; l += pv; }
        l += __shfl_xor(l, 16); l += __shfl_xor(l, 32);
        l += __expf(sink - m);
        f32x4 oa[4];
#pragma unroll
        for (int m4 = 0; m4 < 4; ++m4) oa[m4] = (f32x4){0.f, 0.f, 0.f, 0.f};
        const int tq_ = (cc >> 2), tp_ = cc & 3;
#pragma unroll
        for (int pp = 0; pp < 5; ++pp) {
            v4u pw; pw.x = cvtpk(sc[2 * pp][0], sc[2 * pp][1]); pw.y = cvtpk(sc[2 * pp][2], sc[2 * pp][3]); pw.z = cvtpk(sc[2 * pp + 1][0], sc[2 * pp + 1][1]); pw.w = cvtpk(sc[2 * pp + 1][2], sc[2 * pp + 1][3]);
            const bf16x8_t pf = __builtin_bit_cast(bf16x8_t, pw);
            const int kb0 = 16 * (n0 + 2 * pp) + 4 * g + tq_, kb1 = kb0 + 16;
#pragma unroll
            for (int m4 = 0; m4 < 4; ++m4) {
                const s16x4_t lo = __builtin_bit_cast(s16x4_t, __builtin_amdgcn_ds_read_tr16_b64_v4i16((LAS s16x4_t*)(VB + v_off(kb0, 2 * m4 + (tp_ >> 1)) + (tp_ & 1) * 8)));
                const s16x4_t hi = __builtin_bit_cast(s16x4_t, __builtin_amdgcn_ds_read_tr16_b64_v4i16((LAS s16x4_t*)(VB + v_off(kb1, 2 * m4 + (tp_ >> 1)) + (tp_ & 1) * 8)));
                const bf16x8_t vf = (bf16x8_t){lo[0], lo[1], lo[2], lo[3], hi[0], hi[1], hi[2], hi[3]};
                oa[m4] = __builtin_amdgcn_mfma_f32_16x16x32_bf16(vf, pf, oa[m4], 0, 0, 0);
            }
        }
        asm volatile("s_waitcnt vmcnt(0)" ::: "memory");
        bf16x8_t qfn[2] = {qf[0], qf[1]};
        if (more) att_normq(lds, an, g, qn0, qn1, qfn);
        const float inv = 1.f / l;
        const size_t tok = (size_t)a.b * SEQ + a.c + a.r * (128 * a.j + 16 * wave + cc);
#pragma unroll
        for (int m4 = 0; m4 < 4; ++m4) {
            const unsigned w0 = cvtpk(oa[m4][0] * inv, oa[m4][1] * inv), w1 = cvtpk(oa[m4][2] * inv, oa[m4][3] * inv);
            const unsigned long long pk = (unsigned long long)w0 | ((unsigned long long)w1 << 32);
            const int d = 16 * m4 + 4 * g;
            if (swa) *(unsigned long long*)(MIX + tok * D_MODEL + 512 + 64 * a.h + d) = pk;
            else *(unsigned long long*)(DILO + ((size_t)(a.type - 1) * M_TOK + tok) * 512 + 64 * a.h + d) = pk;
        }
        if (!swa && g == 0) DILL[((size_t)(a.type - 1) * M_TOK + tok) * 8 + a.h] = m + __logf(l);
        ATT_LBAR;
        a = an; qf[0] = qfn[0]; qf[1] = qfn[1];
    }
}

__device__ __forceinline__ void unpack8(const v4u w, float (&o)[8]) {
#pragma unroll
    for (int e = 0; e < 4; ++e) { o[2 * e] = __builtin_bit_cast(float, w[e] << 16); o[2 * e + 1] = __builtin_bit_cast(float, w[e] & 0xffff0000u); }
}
__device__ __forceinline__ void unpack4(const unsigned long long w, float (&o)[4]) {
    const unsigned lo = (unsigned)w, hi = (unsigned)(w >> 32);
    o[0] = __builtin_bit_cast(float, lo << 16); o[1] = __builtin_bit_cast(float, lo & 0xffff0000u); o[2] = __builtin_bit_cast(float, hi << 16); o[3] = __builtin_bit_cast(float, hi & 0xffff0000u);
}
__device__ __forceinline__ void post_token(size_t tok, int lane, const float* __restrict__ Yb, const bf16* __restrict__ Gb, const bf16* __restrict__ Vb, const float* __restrict__ SC2, const float* __restrict__ ln_g, const float* __restrict__ ln_b,
                                           const bf16* __restrict__ DILO, const float* __restrict__ DILL, bf16* __restrict__ MIX) {
    const int c8 = 8 * lane, hh = lane >> 3;
    {
        const f32x4 y0 = *(const f32x4*)(Yb + tok * 512 + c8), y1 = *(const f32x4*)(Yb + tok * 512 + c8 + 4);
        float y[8] = {y0.x, y0.y, y0.z, y0.w, y1.x, y1.y, y1.z, y1.w};
        float sm = 0.f;
#pragma unroll
        for (int e = 0; e < 8; ++e) sm += y[e];
        const float mean = allreduce8(sm) * (1.f / 64.f);
        float sq = 0.f;
#pragma unroll
        for (int e = 0; e < 8; ++e) { y[e] -= mean; sq += y[e] * y[e]; }
        const float rstd = rsqrtf(allreduce8(sq) * (1.f / 64.f) + LN_X_EPS);
        float gg[8]; unpack8(*(const v4u*)(Gb + tok * 512 + c8), gg);
        const float bsc = SC2[(tok * 8 + hh) * 4 + 2];
        float vv8[8]; unpack8(*(const v4u*)(Vb + tok * 512 + c8), vv8);
        const f32x4 lg0 = *(const f32x4*)(ln_g + c8), lg1 = *(const f32x4*)(ln_g + c8 + 4), lb0 = *(const f32x4*)(ln_b + c8), lb1 = *(const f32x4*)(ln_b + c8 + 4);
        const float bb[8] = {vv8[0] * bsc, vv8[1] * bsc, vv8[2] * bsc, vv8[3] * bsc, vv8[4] * bsc, vv8[5] * bsc, vv8[6] * bsc, vv8[7] * bsc};
        const float lg[8] = {lg0.x, lg0.y, lg0.z, lg0.w, lg1.x, lg1.y, lg1.z, lg1.w}, lb[8] = {lb0.x, lb0.y, lb0.z, lb0.w, lb1.x, lb1.y, lb1.z, lb1.w};
        float o[8];
#pragma unroll
        for (int e = 0; e < 8; ++e) o[e] = (y[e] * rstd * lg[e] + lb[e] + bb[e]) * gg[e];
        v4u w; w.x = pk2(o[0], o[1]); w.y = pk2(o[2], o[3]); w.z = pk2(o[4], o[5]); w.w = pk2(o[6], o[7]);
        *(v4u*)(MIX + tok * D_MODEL + 1536 + c8) = w;
    }
    {
        const float l0 = DILL[((size_t)0 * M_TOK + tok) * 8 + hh], l1 = DILL[((size_t)1 * M_TOK + tok) * 8 + hh], l2 = DILL[((size_t)2 * M_TOK + tok) * 8 + hh];
        const float mx = fmaxf(l0, fmaxf(l1, l2));
        float w0 = __expf(l0 - mx), w1 = __expf(l1 - mx), w2 = __expf(l2 - mx);
        const float inv = 1.f / (w0 + w1 + w2); w0 *= inv; w1 *= inv; w2 *= inv;
        const v4u a = *(const v4u*)(DILO + ((size_t)0 * M_TOK + tok) * 512 + c8), bq = *(const v4u*)(DILO + ((size_t)1 * M_TOK + tok) * 512 + c8), cq = *(const v4u*)(DILO + ((size_t)2 * M_TOK + tok) * 512 + c8);
        v4u w;
#pragma unroll
        for (int e = 0; e < 4; ++e) {
            const float lo = w0 * __builtin_bit_cast(float, a[e] << 16) + w1 * __builtin_bit_cast(float, bq[e] << 16) + w2 * __builtin_bit_cast(float, cq[e] << 16);
            const float hi = w0 * __builtin_bit_cast(float, a[e] & 0xffff0000u) + w1 * __builtin_bit_cast(float, bq[e] & 0xffff0000u) + w2 * __builtin_bit_cast(float, cq[e] & 0xffff0000u);
            w[e] = pk2(lo, hi);
        }
        *(v4u*)(MIX + tok * D_MODEL + 1024 + c8) = w;
    }
}

constexpr int RC_AT = 0;
constexpr int RC_RT = 2304;
constexpr int RC_BKT = 4608;
constexpr int RC_VT = 9728;
constexpr int RC_GT = 12800;
constexpr int RC_MT = 14080;
constexpr int RC_NT = 14848;
constexpr int RC_GAM = 15872;
constexpr int RC_BYTES = 16128;
constexpr int RG_AT = 0, RG_RT = 2048, RG_BKT = 4096, RG_VT = 8192, RG_GT = 10240, RG_MT = 11264, RG_NT = 11776, RG_GAM = 12800, RG_BYTES = 13056, RC_PIECES = RG_BYTES / 16;
constexpr int CH_RING = 8;
__device__ __forceinline__ int chain_dst(int pc) {
    if (pc < RG_RT / 16)  { return RC_AT + (pc >> 3) * 144 + (pc & 7) * 16; }
    if (pc < RG_BKT / 16) { const int q = pc - RG_RT / 16;  return RC_RT + (q >> 3) * 144 + (q & 7) * 16; }
    if (pc < RG_VT / 16)  { const int q = pc - RG_BKT / 16; return RC_BKT + (q >> 2) * 80 + (q & 3) * 16; }
    if (pc < RG_GT / 16)  { const int q = pc - RG_VT / 16;  return RC_VT + (q >> 1) * 48 + (q & 1) * 16; }
    if (pc < RG_MT / 16)  { const int q = pc - RG_GT / 16;  return RC_GT + (q >> 2) * 80 + (q & 3) * 16; }
    if (pc < RG_NT / 16)  { const int q = pc - RG_MT / 16;  return RC_MT + (q >> 1) * 48 + (q & 1) * 16; }
    if (pc < RG_GAM / 16) { return RC_NT + (pc - RG_NT / 16) * 16; }
    return RC_GAM + (pc - RG_GAM / 16) * 16;
}
__device__ __forceinline__ bf16x8_t frag2(const LAS unsigned char* p, int second) {
    const unsigned long long lo = *(const LAS unsigned long long*)p, hi = *(const LAS unsigned long long*)(p + second);
    v4u w; w.x = (unsigned)lo; w.y = (unsigned)(lo >> 32); w.z = (unsigned)hi; w.w = (unsigned)(hi >> 32); return __builtin_bit_cast(bf16x8_t, w);
}
#define CHAIN_LBAR do { asm volatile("" ::: "memory"); __builtin_amdgcn_s_waitcnt(0xC07F); __builtin_amdgcn_s_barrier(); asm volatile("" ::: "memory"); } while (0)
__device__ __forceinline__ void chain_wg(LAS unsigned char* lds, int hb, const unsigned char* __restrict__ REC, float* __restrict__ Yb, int tid) {
    asm volatile("" : "+v"(tid));
    const int b = hb >> 3, h = hb & 7;
    const int wave = __builtin_amdgcn_readfirstlane(tid >> 6), lane = tid & 63, g = lane >> 4, c = lane & 15;
    constexpr int NCK = SEQ / 16;
    const unsigned char* rec0 = REC + ((size_t)(b * NCK) * 8 + h) * RG_BYTES;
    const size_t recstep = (size_t)8 * RG_BYTES;
    if (wave >= 4) {
        const int lt = tid - 256;
        int pg[4], pd[4];
#pragma unroll
        for (int k = 0; k < 4; ++k) { int pc = lt + 256 * k; pc = pc < RC_PIECES ? pc : RC_PIECES - 1; pg[k] = pc * 16; pd[k] = chain_dst(pc); }
        v4u L[CH_RING][4];
#pragma unroll
        for (int s = 0; s < CH_RING; ++s)
#pragma unroll
            for (int k = 0; k < 4; ++k) L[s][k] = *(const v4u*)(rec0 + (size_t)s * recstep + pg[k]);
#pragma unroll
        for (int s = 0; s < 2; ++s) {
#pragma unroll
            for (int k = 0; k < 4; ++k) *(LAS v4u*)(lds + s * RC_BYTES + pd[k]) = L[s][k];
#pragma unroll
            for (int k = 0; k < 4; ++k) L[s][k] = *(const v4u*)(rec0 + (size_t)(CH_RING + s) * recstep + pg[k]);
        }
        CHAIN_LBAR;
        int img = 2 * RC_BYTES;
#pragma unroll 1
        for (int ck = 0; ck < NCK; ck += CH_RING) {
#pragma unroll
            for (int q = 0; q < CH_RING; ++q) {
                const int cc = ck + q, s = (q + 2) % CH_RING;
#pragma unroll
                for (int k = 0; k < 4; ++k) *(LAS v4u*)(lds + img + pd[k]) = L[s][k];
                const int nx = (cc + 2 + CH_RING < NCK) ? cc + 2 + CH_RING : NCK - 1;
#pragma unroll
                for (int k = 0; k < 4; ++k) L[s][k] = *(const v4u*)(rec0 + (size_t)nx * recstep + pg[k]);
                img = (img == 2 * RC_BYTES) ? 0 : img + RC_BYTES;
                CHAIN_LBAR;
            }
        }
    } else {
        f32x4 ST[4];
#pragma unroll
        for (int kt = 0; kt < 4; ++kt) ST[kt] = (f32x4){0.f, 0.f, 0.f, 0.f};
        const f32x4 z4 = (f32x4){0.f, 0.f, 0.f, 0.f};
        const bf16x8_t zfrag = (bf16x8_t){0, 0, 0, 0, 0, 0, 0, 0};
        float* yp = Yb + ((size_t)b * SEQ + 4 * g) * 512 + 64 * h + 16 * wave + c;
        const int oA = RC_AT + c * 144 + g * 8, oR = RC_RT + c * 144 + g * 8, oBK = RC_BKT + c * 80 + g * 8, oG = RC_GT + c * 80 + g * 8;
        const int oM = RC_MT + c * 48 + (g & 1) * 16, oV16 = RC_VT + (16 * wave + c) * 48 + (g & 1) * 16, oV8 = RC_VT + (16 * wave + c) * 48 + g * 8, oT = RC_NT + c * 64 + g * 16, oGam = RC_GAM + g * 16;
        struct Ops { bf16x8_t aA0, aA1, aR0, aR1, am, bv, ag, abk[4]; f32x4 tt, gm[4]; unsigned long long vfr; };
#define CHAIN_READ(O, in) do { \
            O.aA0 = frag2((in) + oA, 32); O.aA1 = frag2((in) + oA + 64, 32); O.aR0 = frag2((in) + oR, 32); O.aR1 = frag2((in) + oR + 64, 32);     \
            O.am = *(const LAS bf16x8_t*)((in) + oM); O.bv = *(const LAS bf16x8_t*)((in) + oV16);                                                 \
            O.tt = *(const LAS f32x4*)((in) + oT);                                                                                                \
            O.vfr = *(const LAS unsigned long long*)((in) + oV8);                                                                                 \
            _Pragma("unroll") for (int kt = 0; kt < 4; ++kt) { O.abk[kt] = frag2((in) + oBK + kt * 16 * 80, 32); O.gm[kt] = *(const LAS f32x4*)((in) + oGam + kt * 64); }     \
            O.ag = frag2((in) + oG, 32);                                                                                                          \
        } while (0)
        CHAIN_LBAR;
        Ops opA, opB; CHAIN_READ(opA, lds);
        __builtin_amdgcn_s_waitcnt(0xC07F);
        int img = RC_BYTES;
#define CHAIN_STEP(cur, nxt, cc) do { \
            CHAIN_READ(nxt, lds + img);                                \
            __builtin_amdgcn_sched_barrier(0); \
            if (g >= 2) { cur.am = zfrag; cur.bv = zfrag; } \
              \
            v4u s0, s1; \
            s0.x = cvtpk(ST[0][0], ST[0][1]); s0.y = cvtpk(ST[0][2], ST[0][3]); s0.z = cvtpk(ST[1][0], ST[1][1]); s0.w = cvtpk(ST[1][2], ST[1][3]); \
            s1.x = cvtpk(ST[2][0], ST[2][1]); s1.y = cvtpk(ST[2][2], ST[2][3]); s1.z = cvtpk(ST[3][0], ST[3][1]); s1.w = cvtpk(ST[3][2], ST[3][3]); \
            const bf16x8_t bS0 = __builtin_bit_cast(bf16x8_t, s0), bS1 = __builtin_bit_cast(bf16x8_t, s1); \
              \
            const f32x4 xv = __builtin_amdgcn_mfma_f32_16x16x32_bf16(cur.am, cur.bv, z4, 0, 0, 0), xa = __builtin_amdgcn_mfma_f32_16x16x32_bf16(cur.aA0, bS0, z4, 0, 0, 0), xb = __builtin_amdgcn_mfma_f32_16x16x32_bf16(cur.aA1, bS1, z4, 0, 0, 0); \
            f32x4 xr = __builtin_amdgcn_mfma_f32_16x16x32_bf16(cur.aR0, bS0, z4, 0, 0, 0); \
            xr = __builtin_amdgcn_mfma_f32_16x16x32_bf16(cur.aR1, bS1, xr, 0, 0, 0); \
            const f32x4 x = xa + xb + xv; \
              \
            f32x4 ua = __builtin_amdgcn_mfma_f32_16x16x4f32(cur.tt[0], x[0], z4, 0, 0, 0), ub = __builtin_amdgcn_mfma_f32_16x16x4f32(cur.tt[1], x[1], z4, 0, 0, 0); \
            ua = __builtin_amdgcn_mfma_f32_16x16x4f32(cur.tt[2], x[2], ua, 0, 0, 0); ub = __builtin_amdgcn_mfma_f32_16x16x4f32(cur.tt[3], x[3], ub, 0, 0, 0); \
            const f32x4 u = ua + ub; \
            v4u uvw; uvw.x = cvtpk(u[0], u[1]); uvw.y = cvtpk(u[2], u[3]); uvw.z = (unsigned)cur.vfr; uvw.w = (unsigned)(cur.vfr >> 32);            \
            const bf16x8_t bUV = __builtin_bit_cast(bf16x8_t, uvw); \
              \
            _Pragma("unroll") for (int kt = 0; kt < 4; ++kt) ST[kt] = __builtin_amdgcn_mfma_f32_16x16x32_bf16(cur.abk[kt], bUV, ST[kt] * cur.gm[kt], 0, 0, 0); \
            const f32x4 y = __builtin_amdgcn_mfma_f32_16x16x32_bf16(cur.ag, bUV, xr, 0, 0, 0); \
            _Pragma("unroll") for (int i = 0; i < 4; ++i) yp[(size_t)(16 * (cc) + i) * 512] = y[i]; \
            img = (img == 2 * RC_BYTES) ? 0 : img + RC_BYTES; \
            CHAIN_LBAR; \
        } while (0)
#pragma unroll 1
        for (int cc = 0; cc < NCK; cc += 2) { CHAIN_STEP(opA, opB, cc); CHAIN_STEP(opB, opA, cc + 1); }
#undef CHAIN_STEP
#undef CHAIN_READ
    }
    __syncthreads();
}

struct RwkvP { const float *mu, *w0, *w2, *a0, *a2, *g2, *k_k, *k_a, *r_k, *v0, *v1, *v2; const v4u* lora; };
constexpr int PR_XA = 0;
constexpr int PR_VT = 21248;
constexpr int PR_UP = 58112;
constexpr int PR_U = 135168;
constexpr int PD_TA = 0, PD_TR = 2304, PD_TB = 4608, PD_TK = 6912, PD_TV = 9216, PD_TG = 11520, PD_NT = 11776  , PD_WAVE = 12800, PD_STASH = 8 * PD_WAVE;
__device__ __forceinline__ bf16x8_t pack8(const float (&x)[8]) { v4u w; w.x = cvtpk(x[0], x[1]); w.y = cvtpk(x[2], x[3]); w.z = cvtpk(x[4], x[5]); w.w = cvtpk(x[6], x[7]); return __builtin_bit_cast(bf16x8_t, w); }
__device__ __forceinline__ float fsigmoid(float x) { return 1.f / (1.f + __expf(-x)); }

__device__ __forceinline__ void shifted4(const bf16* __restrict__ colp  , int tl0, bool first, const f32x4 mu, float (&out)[4][4]) {
    float rows[5][4];
#pragma unroll
    for (int ii = 0; ii < 5; ++ii) {
        const int tl = tl0 - 1 + ii;
        if (tl < 0 && first) { rows[ii][0] = 0.f; rows[ii][1] = 0.f; rows[ii][2] = 0.f; rows[ii][3] = 0.f; }
        else unpack4(*(const unsigned long long*)(colp + (ptrdiff_t)tl * IN_W), rows[ii]);
    }
#pragma unroll
    for (int i = 0; i < 4; ++i)
#pragma unroll
        for (int e = 0; e < 4; ++e) out[i][e] = rows[i + 1][e] + (rows[i][e] - rows[i + 1][e]) * mu[e];
}

__device__ __forceinline__ void prep_tile(LAS unsigned char* lds, int tt, int tid, const bf16* __restrict__ PROJ, const float* __restrict__ cw, const RwkvP& W, int layer,
                                          float* __restrict__ scanb, float* __restrict__ sc2, float* __restrict__ vfirst, bf16* __restrict__ MIX) {
    unsigned char* recs = (unsigned char*)scanb;
    asm volatile("" : "+v"(tid));
    const int wave = __builtin_amdgcn_readfirstlane(tid >> 6), lane = tid & 63, g = lane >> 4, c = lane & 15, h = wave;
    const int tok0 = tt * 32; const bool first = (tok0 % SEQ) == 0;
    for (int rp_ = 0; rp_ < REP_P1; ++rp_) {
        const int ti = tid >> 4, t = (tok0 + ti) % SEQ;
        const bf16* row = PROJ + (size_t)(tok0 + ti) * IN_W;
        const v4u z4u = (v4u){0u, 0u, 0u, 0u};
        v4u Lb[4], Lc0[4], Lu0[4], Lc1[4], Lu1[4], Lc2[4], Lu2[4];
#pragma unroll
        for (int qq = 0; qq < 4; ++qq) { const int ch8 = ((tid & 15) + 16 * qq) * 8;
            Lb[qq] = *(const v4u*)(row + OFF_CB + ch8); Lc0[qq] = *(const v4u*)(row + OFF_CC + ch8); Lu0[qq] = *(const v4u*)(row + OFF_CU + ch8);
            Lc1[qq] = (t >= 1) ? *(const v4u*)(row - IN_W + OFF_CC + ch8) : z4u; Lu1[qq] = (t >= 1) ? *(const v4u*)(row - IN_W + OFF_CU + ch8) : z4u;
            Lc2[qq] = (t >= 2) ? *(const v4u*)(row - 2 * IN_W + OFF_CC + ch8) : z4u; Lu2[qq] = (t >= 2) ? *(const v4u*)(row - 2 * IN_W + OFF_CU + ch8) : z4u; }
#pragma unroll
        for (int qq = 0; qq < 4; ++qq) {
            const int ch8 = ((tid & 15) + 16 * qq) * 8;
            float cb[8], c0[8], u0[8], c1[8], u1[8], c2[8], u2[8];
            unpack8(Lb[qq], cb); unpack8(Lc0[qq], c0); unpack8(Lu0[qq], u0); unpack8(Lc1[qq], c1); unpack8(Lu1[qq], u1); unpack8(Lc2[qq], c2); unpack8(Lu2[qq], u2);
            float y[8];
#pragma unroll
            for (int e = 0; e < 8; ++e) y[e] = cb[e] * (cw[ch8 + e] * (c2[e] * u2[e]) + cw[512 + ch8 + e] * (c1[e] * u1[e]) + cw[1024 + ch8 + e] * (c0[e] * u0[e]));
            *(v4u*)(MIX + (size_t)(tok0 + ti) * D_MODEL + ch8) = __builtin_bit_cast(v4u, pack8(y));
        }
    }
    {
        const int ti = tid >> 4, cq = tid & 15, t = (tok0 + ti) % SEQ;
        const bf16* rp = PROJ + (size_t)(tok0 + ti) * IN_W + OFF_RW + 1536 + 16 * cq;
        float cur[16], prv[16];
        unpack8(*(const v4u*)rp, *(float(*)[8])&cur[0]); unpack8(*(const v4u*)(rp + 8), *(float(*)[8])&cur[8]);
        if (t > 0) { unpack8(*(const v4u*)(rp - IN_W), *(float(*)[8])&prv[0]); unpack8(*(const v4u*)(rp - IN_W + 8), *(float(*)[8])&prv[8]); }
        else {
#pragma unroll
            for (int e = 0; e < 16; ++e) prv[e] = 0.f; }
        float x[16];
#pragma unroll
        for (int e = 0; e < 16; ++e) x[e] = cur[e] + (prv[e] - cur[e]) * W.mu[1536 + 16 * cq + e];
        if (cq < 4) {
#pragma unroll
            for (int e = 0; e < 16; ++e) x[e] = 1.f - 2.f / (1.f + __expf(2.f * x[e]));
        } else if (cq >= 8) {
#pragma unroll
            for (int e = 0; e < 16; ++e) x[e] = fsigmoid(x[e]); }
        LAS unsigned char* xa = lds + PR_XA + ti * 528 + 16 * cq * 2;
        *(LAS bf16x8_t*)xa = pack8(*(float(*)[8])&x[0]); *(LAS bf16x8_t*)(xa + 16) = pack8(*(float(*)[8])&x[8]);
    }
    __syncthreads();
    const int ch = 64 * h + 4 * c;
    const size_t SB = (size_t)M_TOK * 512;
    f32x4 decr[2][4];
    for (int rp_ = 0; rp_ < REP_P2; ++rp_) {
        f32x4 az[2][4];
#pragma unroll
        for (int mt = 0; mt < 2; ++mt)
#pragma unroll
            for (int nt = 0; nt < 4; ++nt) az[mt][nt] = (f32x4){0.f, 0.f, 0.f, 0.f};
#pragma unroll
        for (int ks = 0; ks < 2; ++ks) {
            f32x4 bw[8];
#pragma unroll
            for (int jx = 0; jx < 8; ++jx) bw[jx] = *(const f32x4*)(W.w2 + (size_t)(32 * ks + 8 * g + jx) * 512 + 64 * h + 4 * c);
            const bf16x8_t af0 = *(const LAS bf16x8_t*)(lds + PR_XA + c * 528 + (32 * ks + 8 * g) * 2), af1 = *(const LAS bf16x8_t*)(lds + PR_XA + (16 + c) * 528 + (32 * ks + 8 * g) * 2);
#pragma unroll
            for (int nt = 0; nt < 4; ++nt) {
                const float col[8] = {bw[0][nt], bw[1][nt], bw[2][nt], bw[3][nt], bw[4][nt], bw[5][nt], bw[6][nt], bw[7][nt]};
                const bf16x8_t bf = pack8(col);
                az[0][nt] = __builtin_amdgcn_mfma_f32_16x16x32_bf16(af0, bf, az[0][nt], 0, 0, 0); az[1][nt] = __builtin_amdgcn_mfma_f32_16x16x32_bf16(af1, bf, az[1][nt], 0, 0, 0);
            }
        }
        const f32x4 w0v = *(const f32x4*)(W.w0 + ch);
#pragma unroll
        for (int mt = 0; mt < 2; ++mt)
#pragma unroll
            for (int i = 0; i < 4; ++i) {
#pragma unroll
                for (int e = 0; e < 4; ++e) decr[mt][i][e] = __expf(-0.60653065971f * fsigmoid(az[mt][e][i] + w0v[e])); }
    }
    f32x4 av[2][4];
    for (int rp_ = 0; rp_ < REP_P3; ++rp_) {
        f32x4 aa[2][4], ag[2][4];
#pragma unroll
        for (int mt = 0; mt < 2; ++mt)
#pragma unroll
            for (int nt = 0; nt < 4; ++nt) { aa[mt][nt] = (f32x4){0.f, 0.f, 0.f, 0.f}; ag[mt][nt] = (f32x4){0.f, 0.f, 0.f, 0.f}; }
#pragma unroll
        for (int half = 0; half < 2; ++half) {
            v4u fr[3][4];
#pragma unroll
            for (int k3 = 0; k3 < 3; ++k3)
#pragma unroll
                for (int nt = 0; nt < 4; ++nt) fr[k3][nt] = W.lora[(((3 * half + k3) * 8 + h) * 4 + nt) * 64 + lane];
#pragma unroll
            for (int k3 = 0; k3 < 3; ++k3) {
                const int ks = 3 * half + k3;
                const bf16x8_t af0 = *(const LAS bf16x8_t*)(lds + PR_XA + c * 528 + (64 + 32 * ks + 8 * g) * 2), af1 = *(const LAS bf16x8_t*)(lds + PR_XA + (16 + c) * 528 + (64 + 32 * ks + 8 * g) * 2);
#pragma unroll
                for (int nt = 0; nt < 4; ++nt) {
                    const bf16x8_t bf = __builtin_bit_cast(bf16x8_t, fr[k3][nt]);
                    if (ks < 2) { aa[0][nt] = __builtin_amdgcn_mfma_f32_16x16x32_bf16(af0, bf, aa[0][nt], 0, 0, 0); aa[1][nt] = __builtin_amdgcn_mfma_f32_16x16x32_bf16(af1, bf, aa[1][nt], 0, 0, 0); }
                    else { ag[0][nt] = __builtin_amdgcn_mfma_f32_16x16x32_bf16(af0, bf, ag[0][nt], 0, 0, 0); ag[1][nt] = __builtin_amdgcn_mfma_f32_16x16x32_bf16(af1, bf, ag[1][nt], 0, 0, 0); }
                }
            }
        }
        const f32x4 a0v = *(const f32x4*)(W.a0 + ch);
#pragma unroll
        for (int mt = 0; mt < 2; ++mt)
#pragma unroll
            for (int i = 0; i < 4; ++i) { f32x4 gv;
#pragma unroll
                for (int e = 0; e < 4; ++e) { gv[e] = ag[mt][e][i]; av[mt][i][e] = fsigmoid(aa[mt][e][i] + a0v[e]); }
                *(unsigned long long*)((bf16*)(scanb + 6 * SB) + (size_t)(tok0 + 16 * mt + 4 * g + i) * 512 + ch) = (unsigned long long)cvtpk(gv[0], gv[1]) | ((unsigned long long)cvtpk(gv[2], gv[3]) << 32); }
    }
    asm volatile("" ::: "memory");
    const bf16* rwp = PROJ + (size_t)tok0 * IN_W + OFF_RW + 64 * h + 4 * c;
    const f32x4 mu_r = *(const f32x4*)(W.mu + 64 * h + 4 * c), mu_k = *(const f32x4*)(W.mu + 512 + 64 * h + 4 * c), mu_v = *(const f32x4*)(W.mu + 1024 + 64 * h + 4 * c);
    f32x4 agt[2][4];
    if (layer > 0) {
        LAS unsigned char* vt = lds + PR_VT + wave * 4608;
#pragma unroll
        for (int mt = 0; mt < 2; ++mt) {
            float vv[4][4];
            shifted4(rwp + 1024, 16 * mt + 4 * g, first, mu_v, vv);
#pragma unroll
            for (int i = 0; i < 4; ++i) *(LAS unsigned long long*)(vt + ((16 * mt + 4 * g + i) * 72 + 4 * c) * 2) = (unsigned long long)cvtpk(vv[i][0], vv[i][1]) | ((unsigned long long)cvtpk(vv[i][2], vv[i][3]) << 32);
        }
        f32x4 au[2][2];
#pragma unroll
        for (int mt = 0; mt < 2; ++mt)
#pragma unroll
            for (int n2 = 0; n2 < 2; ++n2) au[mt][n2] = (f32x4){0.f, 0.f, 0.f, 0.f};
#pragma unroll
        for (int ks = 0; ks < 2; ++ks) {
            const bf16x8_t af0 = *(const LAS bf16x8_t*)(vt + (c * 72 + 32 * ks + 8 * g) * 2), af1 = *(const LAS bf16x8_t*)(vt + ((16 + c) * 72 + 32 * ks + 8 * g) * 2);
#pragma unroll
            for (int n2 = 0; n2 < 2; ++n2) {
                float col[8];
#pragma unroll
                for (int jx = 0; jx < 8; ++jx) col[jx] = W.v1[(size_t)(64 * h + 32 * ks + 8 * g + jx) * 32 + 16 * n2 + c];
                const bf16x8_t bf = pack8(col);
                au[0][n2] = __builtin_amdgcn_mfma_f32_16x16x32_bf16(af0, bf, au[0][n2], 0, 0, 0); au[1][n2] = __builtin_amdgcn_mfma_f32_16x16x32_bf16(af1, bf, au[1][n2], 0, 0, 0);
            }
        }
        LAS float* up = (LAS float*)(lds + PR_UP) + wave * 1056;
#pragma unroll
        for (int mt = 0; mt < 2; ++mt)
#pragma unroll
            for (int n2 = 0; n2 < 2; ++n2)
#pragma unroll
                for (int i = 0; i < 4; ++i) up[(16 * mt + 4 * g + i) * 33 + 16 * n2 + c] = au[mt][n2][i];
        __syncthreads();
#pragma unroll
        for (int o2 = 0; o2 < 2; ++o2) { const int o = tid + 512 * o2, tk = o >> 5, n = o & 31; float sacc = 0.f;
#pragma unroll
            for (int w8 = 0; w8 < 8; ++w8) sacc += ((const LAS float*)(lds + PR_UP))[w8 * 1056 + tk * 33 + n];
            ((LAS float*)(lds + PR_U))[tk * 36 + n] = sacc; }
        __syncthreads();
        f32x4 bw[8];
#pragma unroll
        for (int jx = 0; jx < 8; ++jx) bw[jx] = *(const f32x4*)(W.v2 + (size_t)(8 * g + jx) * 512 + 64 * h + 4 * c);
        bf16x8_t afm[2];
#pragma unroll
        for (int mt = 0; mt < 2; ++mt) { const LAS float* ur = (const LAS float*)(lds + PR_U) + (16 * mt + c) * 36 + 8 * g; float uu[8];
#pragma unroll
            for (int jx = 0; jx < 8; ++jx) uu[jx] = ur[jx];
            afm[mt] = pack8(uu); }
#pragma unroll
        for (int nt = 0; nt < 4; ++nt) {
            const float col[8] = {bw[0][nt], bw[1][nt], bw[2][nt], bw[3][nt], bw[4][nt], bw[5][nt], bw[6][nt], bw[7][nt]};
            const bf16x8_t bf = pack8(col);
            agt[0][nt] = __builtin_amdgcn_mfma_f32_16x16x32_bf16(afm[0], bf, (f32x4){0.f, 0.f, 0.f, 0.f}, 0, 0, 0);
            agt[1][nt] = __builtin_amdgcn_mfma_f32_16x16x32_bf16(afm[1], bf, (f32x4){0.f, 0.f, 0.f, 0.f}, 0, 0, 0);
        }
    }
    __syncthreads();
    LAS unsigned long long* stash_av = (LAS unsigned long long*)(lds + PD_STASH + wave * 4096);
    LAS unsigned long long* stash_gt = (LAS unsigned long long*)(lds + PD_STASH + wave * 4096 + 2048);
#pragma unroll
    for (int i = 0; i < 4; ++i) stash_av[i * 64 + lane] = (unsigned long long)cvtpk(av[1][i][0], av[1][i][1]) | ((unsigned long long)cvtpk(av[1][i][2], av[1][i][3]) << 32);
    if (layer > 0) {
#pragma unroll
        for (int e = 0; e < 4; ++e) stash_gt[e * 64 + lane] = (unsigned long long)cvtpk(agt[1][e][0], agt[1][e][1]) | ((unsigned long long)cvtpk(agt[1][e][2], agt[1][e][3]) << 32); }
    const f32x4 kkv = *(const f32x4*)(W.k_k + ch), kav = *(const f32x4*)(W.k_a + ch), rkv = *(const f32x4*)(W.r_k + ch);
    f32x4 v0v = (f32x4){0.f, 0.f, 0.f, 0.f}; if (layer > 0) v0v = *(const f32x4*)(W.v0 + ch);
    LAS unsigned char* pt = lds + wave * PD_WAVE;
    for (int rp_ = 0; rp_ < REP_P4; ++rp_)
#pragma unroll
    for (int mt = 0; mt < 2; ++mt) {
        asm volatile("" ::: "memory");
        unsigned char* rec = recs + ((size_t)((tok0 + 16 * mt) >> 4) * 8 + h) * RG_BYTES;
        f32x4 avm[4], agm[4];
        if (mt == 0) {
#pragma unroll
            for (int i = 0; i < 4; ++i) { avm[i] = av[0][i]; agm[i] = agt[0][i]; }
        } else {
#pragma unroll
            for (int i = 0; i < 4; ++i) { float t4[4]; unpack4(stash_av[i * 64 + lane], t4); avm[i] = (f32x4){t4[0], t4[1], t4[2], t4[3]};
                if (layer > 0) { unpack4(stash_gt[i * 64 + lane], t4); agm[i] = (f32x4){t4[0], t4[1], t4[2], t4[3]}; } else agm[i] = (f32x4){0.f, 0.f, 0.f, 0.f}; }
        }
        float rr[4][4], kx[4][4], vv[4][4];
        f32x4 gm[4], Eg, Gtot;
        {
#pragma unroll
            for (int i = 0; i < 4; ++i) { const f32x4 d = decr[mt][i];
                gm[i] = (i == 0) ? d : gm[i > 0 ? i - 1 : 0] * d; }
            f32x4 t0, t1, t2, t3;
#pragma unroll
            for (int e = 0; e < 4; ++e) { t0[e] = __shfl(gm[3][e], c); t1[e] = __shfl(gm[3][e], c + 16); t2[e] = __shfl(gm[3][e], c + 32); t3[e] = __shfl(gm[3][e], c + 48); }
            Eg = (g == 0) ? (f32x4){1.f, 1.f, 1.f, 1.f} : (g == 1) ? t0 : (g == 2) ? t0 * t1 : t0 * t1 * t2;
            Gtot = (t0 * t1) * (t2 * t3);
            if (g == 0) { *(f32x4*)(rec + RG_GAM + 16 * c) = Gtot; *(LAS f32x4*)(pt + PD_TG + 16 * c) = Gtot; }
#pragma unroll
            for (int i = 0; i < 4; ++i) gm[i] = gm[i] * Eg;
        }
        asm volatile("" ::: "memory");
        shifted4(rwp, 16 * mt + 4 * g, first, mu_r, rr); shifted4(rwp + 512, 16 * mt + 4 * g, first, mu_k, kx); shifted4(rwp + 1024, 16 * mt + 4 * g, first, mu_v, vv);
#pragma unroll
        for (int i = 0; i < 4; ++i) {
            const size_t o = (size_t)(tok0 + 16 * mt + 4 * g + i) * 512 + ch;
            f32x4 vo, kkq, kmq, ro;
            float ssq = 0.f, bsum = 0.f;
#pragma unroll
            for (int e = 0; e < 4; ++e) {
                ro[e] = rr[i][e];
                kkq[e] = kx[i][e] * kkv[e]; ssq += kkq[e] * kkq[e];
                kmq[e] = kx[i][e] * (1.f + (avm[i][e] - 1.f) * kav[e]);
                bsum += rr[i][e] * kmq[e] * rkv[e];
            }
            if (layer > 0) { float vf[4]; unpack4(*(const unsigned long long*)((const bf16*)vfirst + o), vf);
#pragma unroll
                for (int e = 0; e < 4; ++e) vo[e] = vv[i][e] + (vf[e] - vv[i][e]) * fsigmoid(v0v[e] + agm[e][i]); }
            else { vo = (f32x4){vv[i][0], vv[i][1], vv[i][2], vv[i][3]}; *(unsigned long long*)((bf16*)vfirst + o) = (unsigned long long)cvtpk(vo[0], vo[1]) | ((unsigned long long)cvtpk(vo[2], vo[3]) << 32); }
            ssq = allreduce16(ssq); bsum = allreduce16(bsum);
            const float rn = rsqrtf(fmaxf(ssq, 1e-24f));
            f32x4 an, bn;
#pragma unroll
            for (int e = 0; e < 4; ++e) { const float kn = kkq[e] * rn; an[e] = -kn; bn[e] = kn * avm[i][e]; }
            if (c == 0) *(f32x4*)(sc2 + ((size_t)(tok0 + 16 * mt + 4 * g + i) * 8 + h) * 4) = (f32x4){0.f, 0.f, bsum, 0.f};
            const f32x4 gam = gm[i], gamp = (i == 0) ? Eg : gm[i > 0 ? i - 1 : 0];
            const f32x4 ginv = (f32x4){__builtin_amdgcn_rcpf(gam[0]), __builtin_amdgcn_rcpf(gam[1]), __builtin_amdgcn_rcpf(gam[2]), __builtin_amdgcn_rcpf(gam[3])};
            const f32x4 rt = ro * gam, at = an * gamp, bt = bn * ginv, kt = kmq * ginv;
#define PK4(val) ((unsigned long long)cvtpk((val)[0], (val)[1]) | ((unsigned long long)cvtpk((val)[2], (val)[3]) << 32))
            const unsigned long long pa = PK4(at), pr = PK4(rt), pb = PK4(bt), pk = PK4(kt), pv = PK4(vo);
#undef PK4
            const int trow = (4 * g + i) * 144 + 8 * c;
            const int grow = (4 * g + i) * 128 + 8 * c;
            *(unsigned long long*)(rec + RG_AT + grow) = pa; *(unsigned long long*)(rec + RG_RT + grow) = pr;
            *(LAS unsigned long long*)(pt + PD_TA + trow) = pa; *(LAS unsigned long long*)(pt + PD_TR + trow) = pr; *(LAS unsigned long long*)(pt + PD_TB + trow) = pb;
            *(LAS unsigned long long*)(pt + PD_TK + trow) = pk; *(LAS unsigned long long*)(pt + PD_TV + trow) = pv;
            *(unsigned long long*)((bf16*)(scanb + 5 * SB) + o) = pv;
        }
        {
            f32x4 nN = (f32x4){0.f, 0.f, 0.f, 0.f}, nM = nN, nG1 = nN, nG2 = nN;
#pragma unroll
            for (int ks = 0; ks < 2; ++ks) { const int fo = c * 144 + ks * 64 + g * 16;
                const bf16x8_t fB = *(const LAS bf16x8_t*)(pt + PD_TB + fo), fK = *(const LAS bf16x8_t*)(pt + PD_TK + fo), fA = *(const LAS bf16x8_t*)(pt + PD_TA + fo), fR = *(const LAS bf16x8_t*)(pt + PD_TR + fo);
                nN = __builtin_amdgcn_mfma_f32_16x16x32_bf16(fB, fA, nN, 0, 0, 0); nM = __builtin_amdgcn_mfma_f32_16x16x32_bf16(fK, fA, nM, 0, 0, 0);
                nG1 = __builtin_amdgcn_mfma_f32_16x16x32_bf16(fB, fR, nG1, 0, 0, 0); nG2 = __builtin_amdgcn_mfma_f32_16x16x32_bf16(fK, fR, nG2, 0, 0, 0); }
#pragma unroll
            for (int i = 0; i < 4; ++i) { const int j = 4 * g + i; if (j >= c) { nN[i] = 0.f; nM[i] = 0.f; } if (j > c) { nG1[i] = 0.f; nG2[i] = 0.f; } }
            LAS float* nt = (LAS float*)(pt + PD_NT);
            *(LAS f32x4*)(nt + c * 16 + 4 * g) = nN;
            {
                float tr[16];
#pragma unroll
                for (int t = 0; t < 16; ++t) tr[t] = (t == c) ? 1.f : 0.f;
#pragma unroll
                for (int t = 1; t < 16; ++t) {
#pragma unroll
                    for (int jb = 0; jb * 4 < t; ++jb) { const f32x4 n4 = *(const LAS f32x4*)(nt + t * 16 + jb * 4);
                        tr[t] = fmaf(tr[4 * jb], n4[0], tr[t]); if (4 * jb + 1 < t) tr[t] = fmaf(tr[4 * jb + 1], n4[1], tr[t]); if (4 * jb + 2 < t) tr[t] = fmaf(tr[4 * jb + 2], n4[2], tr[t]); if (4 * jb + 3 < t) tr[t] = fmaf(tr[4 * jb + 3], n4[3], tr[t]); }
                }
                if (g == 0) {
#pragma unroll
                    for (int t = 0; t < 16; ++t) *(float*)(rec + RG_NT + t * 64 + c * 4) = tr[t];
                }
            }
            *(unsigned long long*)(rec + RG_MT + c * 32 + g * 8) = (unsigned long long)cvtpk(nM[0], nM[1]) | ((unsigned long long)cvtpk(nM[2], nM[3]) << 32);
            *(unsigned long long*)(rec + RG_GT + c * 64 + g * 8) = (unsigned long long)cvtpk(nG1[0], nG1[1]) | ((unsigned long long)cvtpk(nG1[2], nG1[3]) << 32);
            *(unsigned long long*)(rec + RG_GT + c * 64 + 32 + g * 8) = (unsigned long long)cvtpk(nG2[0], nG2[1]) | ((unsigned long long)cvtpk(nG2[2], nG2[3]) << 32);
        }
        {
            const int tro = (4 * g + (c >> 2)) * 144 + (c & 3) * 8;
#pragma unroll
            for (int m = 0; m < 4; ++m) {
                const float gch = *(const LAS float*)(pt + PD_TG + (16 * m + c) * 4);
                const unsigned long long tb = __builtin_bit_cast(unsigned long long, __builtin_amdgcn_ds_read_tr16_b64_v4i16((LAS s16x4_t*)(pt + PD_TB + tro + m * 32)));
                const unsigned long long tk = __builtin_bit_cast(unsigned long long, __builtin_amdgcn_ds_read_tr16_b64_v4i16((LAS s16x4_t*)(pt + PD_TK + tro + m * 32)));
                const unsigned long long tv = __builtin_bit_cast(unsigned long long, __builtin_amdgcn_ds_read_tr16_b64_v4i16((LAS s16x4_t*)(pt + PD_TV + tro + m * 32)));
                float fb[4], fk[4]; unpack4(tb, fb); unpack4(tk, fk);
                unsigned char* brow = rec + RG_BKT + (16 * m + c) * 64 + g * 8;
                *(unsigned long long*)brow = (unsigned long long)cvtpk(fb[0] * gch, fb[1] * gch) | ((unsigned long long)cvtpk(fb[2] * gch, fb[3] * gch) << 32);
                *(unsigned long long*)(brow + 32) = (unsigned long long)cvtpk(fk[0] * gch, fk[1] * gch) | ((unsigned long long)cvtpk(fk[2] * gch, fk[3] * gch) << 32);
                *(unsigned long long*)(rec + RG_VT + (16 * m + c) * 32 + g * 8) = tv;
            }
        }
    }
    __syncthreads();
}

typedef GAS unsigned gu32;
#define RLX_AGENT __ATOMIC_RELAXED, __HIP_MEMORY_SCOPE_AGENT
#define XB_TMO      128
#define XB_XCNT(j)  (256  + 64 * (j))
#define XB_XSUB(j)  (1280 + 64 * (j))
#define XB_XGEN(j)  (2304 + 64 * (j))
#define XB_TOP      3328
#define XB_TOPGEN   3392
#define XCD_BAR_WORDS 3456
#define XB_SPIN_CAP (1u << 18)

__device__ __forceinline__ unsigned xb_ld(unsigned* p)              { return __hip_atomic_load(p, __ATOMIC_RELAXED, __HIP_MEMORY_SCOPE_AGENT); }
__device__ __forceinline__ unsigned xb_add(unsigned* p, unsigned v) { return __hip_atomic_fetch_add(p, v, __ATOMIC_RELAXED, __HIP_MEMORY_SCOPE_AGENT); }
__device__ __forceinline__ unsigned xb_xcc_id() { return (unsigned)__builtin_amdgcn_s_getreg((3 << 11) | 20) & 0xFu; }
#define XB_SPIN(cond, bar) do { unsigned _sp = 0; while (cond) { __builtin_amdgcn_s_sleep(1); \
    if ((++_sp & 255u) == 0u) { if (xb_ld(&(bar)[XB_TMO])) break; if (_sp > XB_SPIN_CAP) { atomicAdd(&(bar)[XB_TMO], 1u); break; } } } } while (0)

struct XcdBarrier {
    unsigned* bar; unsigned x;
    volatile LAS unsigned* st;
};

__device__ __forceinline__ XcdBarrier xcd_barrier_post(unsigned* bar, volatile LAS unsigned* st) {
    XcdBarrier b; b.bar = bar; b.x = xb_xcc_id(); b.st = st;
    if (threadIdx.x == 0) (void)xb_add(&bar[XB_XCNT(b.x)], 1u);
    return b;
}
__device__ __forceinline__ void xcd_barrier_complete(unsigned* bar, unsigned x, unsigned& nloc, unsigned& nx) {
    const unsigned G = gridDim.x * gridDim.y * gridDim.z;
    unsigned sum, cnt, mine, sp = 0u;
    for (;;) {
        sum = 0u; cnt = 0u; mine = 0u;
#pragma unroll
        for (unsigned j = 0; j < 16; ++j) { const unsigned c = xb_ld(&bar[XB_XCNT(j)]); sum += c; cnt += (c > 0u) ? 1u : 0u; mine = (j == x) ? c : mine; }
        if (sum == G) break;
        __builtin_amdgcn_s_sleep(1);
        if ((++sp & 255u) == 0u) { if (xb_ld(&bar[XB_TMO])) break; if (sp > XB_SPIN_CAP) { atomicAdd(&bar[XB_TMO], 1u); break; } }
    }
    nloc = mine > 0u ? mine : 1u; nx = cnt > 0u ? cnt : 1u;
}

__device__ __forceinline__ void xcd_barrier(const XcdBarrier& b) {
    asm volatile("s_waitcnt vmcnt(0)" ::: "memory");
    __syncthreads();
    if (threadIdx.x == 0) {
        unsigned* bar = b.bar;
        __builtin_amdgcn_s_waitcnt(0);
        unsigned nloc = b.st[0], nx = b.st[1];
        if (nloc == 0u) { xcd_barrier_complete(bar, b.x, nloc, nx); b.st[0] = nloc; b.st[1] = nx; }
        const unsigned old = xb_add(&bar[XB_XSUB(b.x)], 1u);
        const unsigned gen = old / nloc;
        if (old + 1u == (gen + 1u) * nloc) {
            __builtin_amdgcn_fence(__ATOMIC_RELEASE, "agent");
            asm volatile("s_waitcnt vmcnt(0)" ::: "memory");
            const unsigned og = xb_add(&bar[XB_TOP], 1u);
            const unsigned tg = og / nx;
            if (og + 1u == (tg + 1u) * nx) xb_add(&bar[XB_TOPGEN], 1u);
            else XB_SPIN(xb_ld(&bar[XB_TOPGEN]) == tg, bar);
            __builtin_amdgcn_fence(__ATOMIC_ACQUIRE, "agent");
            xb_add(&bar[XB_XGEN(b.x)], 1u);
            asm volatile("s_waitcnt vmcnt(0)" ::: "memory");
        } else {
            XB_SPIN(xb_ld(&bar[XB_XGEN(b.x)]) == gen, bar);
            __builtin_amdgcn_fence(__ATOMIC_ACQUIRE, "agent");
            asm volatile("s_waitcnt vmcnt(0)" ::: "memory");
        }
    }
    __syncthreads();
}


constexpr int NWAVES = 8;
constexpr size_t MiB = 1u << 20;
constexpr size_t WS_CTL = 0;
constexpr size_t WS_WT = 2 * MiB;
constexpr size_t WT_LAYER = 94 * MiB, WT_IN = 0, WT_OUT = 22 * MiB, WT_UP = 30 * MiB, WT_DOWN = 62 * MiB;
constexpr size_t WS_HN = 192 * MiB;
constexpr size_t WS_VFIRST = 224 * MiB;
constexpr size_t WS_PROJ = 240 * MiB;
constexpr size_t WS_MIX = 328 * MiB;
constexpr size_t WS_SCAN = 360 * MiB;
constexpr size_t WS_H = 240 * MiB;
constexpr size_t OUT_DILO = 0, OUT_DILL = 24 * MiB, OUT_SC2 = 25 * MiB;
constexpr size_t WS_SSPF = 190 * MiB;
constexpr size_t WS_LORA = 191 * MiB;
constexpr size_t WS_SSP = 1 * MiB;
constexpr size_t WS_END = 504 * MiB;
constexpr int N_SCAN_WG = BATCH * 8;
constexpr int LDS_BYTES = 147456;

struct Params { const float* in[28]; float* out; unsigned char* ws; int ph_lo, ph_hi; };

__device__ __forceinline__ void transpose_item(const float* W, int K, int N, bf16* WT, LAS float* scr, int item, int lane) {
    const int nblk = N / 32, kb = item / nblk, nb = item % nblk, k0 = 64 * kb, n0 = 32 * nb;
    const int kr = lane >> 3, nq = lane & 7;
    f32x4 v[8];
#pragma unroll
    for (int i = 0; i < 8; ++i) v[i] = __builtin_nontemporal_load((const f32x4*)(W + (size_t)(k0 + 8 * i + kr) * N + n0 + 4 * nq));
#pragma unroll
    for (int i = 0; i < 8; ++i) { LAS float* d = scr + (8 * i + kr) * 33 + 4 * nq; d[0] = v[i].x; d[1] = v[i].y; d[2] = v[i].z; d[3] = v[i].w; }
    asm volatile("s_waitcnt lgkmcnt(0)" ::: "memory");
    const int c = lane & 7;
#pragma unroll
    for (int j = 0; j < 4; ++j) { const int n = (lane >> 3) + 8 * j; const LAS float* s = scr + (8 * c) * 33 + n;
        v4u o; o.x = pk2(s[0 * 33], s[1 * 33]); o.y = pk2(s[2 * 33], s[3 * 33]); o.z = pk2(s[4 * 33], s[5 * 33]); o.w = pk2(s[6 * 33], s[7 * 33]);
        *(v4u*)(WT + (size_t)(n0 + n) * K + k0 + 8 * c) = o; }
    asm volatile("s_waitcnt lgkmcnt(0)" ::: "memory");
}
__device__ __forceinline__ void row_to_bf16_ssq(const float* xrow, const float* g, bf16* orow, float* ssprow, int lane) {
    const f32x4* xr = (const f32x4*)xrow + lane; const f32x4* gr = (const f32x4*)g + lane;
    f32x4 v[8]; float s = 0.f;
#pragma unroll
    for (int j = 0; j < 8; ++j) { v[j] = xr[64 * j]; s += (v[j].x * v[j].x + v[j].y * v[j].y) + (v[j].z * v[j].z + v[j].w * v[j].w); }
    s = wave_sum(s);
    if (lane < 32) ssprow[lane] = (lane == 0) ? s : 0.f;
    unsigned long long* o8 = (unsigned long long*)orow + lane;
#pragma unroll
    for (int j = 0; j < 8; ++j) { const f32x4 gg = gr[64 * j]; o8[64 * j] = (unsigned long long)pk2(v[j].x * gg.x, v[j].y * gg.y) | ((unsigned long long)pk2(v[j].z * gg.z, v[j].w * gg.w) << 32); }
}

__device__ __forceinline__ void conv_job(const Params& p, unsigned char* ws, int l, int i0, int i1, int wv, int nw, LAS float* scr, int lane) {
    unsigned char* wtl = ws + WS_WT + l * WT_LAYER;
    constexpr int I_OUT = (D_MODEL / 64) * (D_MODEL / 32), I_UP = (D_MODEL / 64) * (D_FF / 32), I_DOWN = (D_FF / 64) * (D_MODEL / 32);
    for (int it = i0 + wv; it < i1; it += nw) {
        int r = it;
        if (r >= I_OUT + I_UP + I_DOWN) { transpose_item(p.in[2] + (size_t)(l + 1) * D_MODEL * IN_W, D_MODEL, IN_W, (bf16*)(ws + WS_WT + (l + 1) * WT_LAYER + WT_IN), scr, r - (I_OUT + I_UP + I_DOWN), lane); continue; }
        if (r < I_OUT) { transpose_item(p.in[23] + (size_t)l * D_MODEL * D_MODEL, D_MODEL, D_MODEL, (bf16*)(wtl + WT_OUT), scr, r, lane); continue; } r -= I_OUT;
        if (r < I_UP) { transpose_item(p.in[25] + (size_t)l * D_MODEL * D_FF, D_MODEL, D_FF, (bf16*)(wtl + WT_UP), scr, r, lane); continue; } r -= I_UP;
        transpose_item(p.in[26] + (size_t)l * D_FF * D_MODEL, D_FF, D_MODEL, (bf16*)(wtl + WT_DOWN), scr, r, lane);
    }
}
constexpr int CJ_TOTAL = (D_MODEL / 64) * (D_MODEL / 32) + (D_MODEL / 64) * (D_FF / 32) + (D_FF / 64) * (D_MODEL / 32);
#ifndef CJ_EARLY
#define CJ_EARLY 6144
#endif
constexpr int GIN_FULL = (M_TOK / 256) * (IN_W / 256) - 2 * 256;

#ifndef DUP_SUB
#define DUP_SUB (-1)
#endif
#ifndef REP_SCAN
#define REP_SCAN 1
#endif
#ifndef REP_ATT
#define REP_ATT 1
#define STAGGER_UP 6
#endif
#ifndef DUP0
#define DUP0 0
#endif
constexpr int PH_PER_LAYER = 7, SLOTS = PH_PER_LAYER + (DUP_SUB >= 0 ? 1 : 0), N_PHASES = 1 + DUP0 + SLOTS * DEPTH;

__global__ void __launch_bounds__(NWAVES * 64, 2) mk_fwd(Params p) {
    extern __shared__ __attribute__((aligned(16))) unsigned char lds_raw[];
    LAS unsigned char* lds = (LAS unsigned char*)lds_raw;
    const int wave = __builtin_amdgcn_readfirstlane((int)threadIdx.x >> 6);
    const int G = gridDim.x, bx = blockIdx.x;
    const int gw = bx * NWAVES + wave, NGW = G * NWAVES;
    unsigned char* ws = p.ws;
    bf16* HN = (bf16*)(ws + WS_HN); bf16* PROJ = (bf16*)(ws + WS_PROJ); bf16* MIX = (bf16*)(ws + WS_MIX); bf16* HB = (bf16*)(ws + WS_H); float* SSP = (float*)(ws + WS_SSP); float* SSPF = (float*)(ws + WS_SSPF);
    volatile LAS unsigned* bst = (volatile LAS unsigned*)(lds + LDS_BYTES - 64);
    if (threadIdx.x < 16) bst[threadIdx.x] = 0u;
    __syncthreads();
    XcdBarrier xbar = xcd_barrier_post((unsigned*)(ws + WS_CTL), bst);
    for (int ph = p.ph_lo; ph < p.ph_hi; ++ph) {
        if (ph > p.ph_lo) xcd_barrier(xbar);
        int tid = threadIdx.x; asm volatile("" : "+v"(tid));
        const int lane = tid & 63;
        if (ph <= DUP0) {
            LAS float* scr = (LAS float*)(lds + wave * 16384);
            constexpr int I_IN = (D_MODEL / 64) * (IN_W / 32);
            for (int it = gw; it < I_IN; it += NGW) transpose_item(p.in[2], D_MODEL, IN_W, (bf16*)(ws + WS_WT + WT_IN), scr, it, lane);
            {
                v4u* FR = (v4u*)(ws + WS_LORA);
                for (int idx = (int)blockIdx.x * (NWAVES * 64) + tid; idx < DEPTH * 6 * 8 * 4 * 64; idx += (int)gridDim.x * (NWAVES * 64)) {
                    const int ln = idx & 63, nt = (idx >> 6) & 3, hh = (idx >> 8) & 7, ks = (idx >> 11) % 6, ll = (idx >> 11) / 6, gg = ln >> 4, cc = ln & 15;
                    const float* Wt = (ks < 2) ? p.in[13] + (size_t)ll * 64 * 512 + (size_t)(32 * ks + 8 * gg) * 512 : p.in[14] + (size_t)ll * 128 * 512 + (size_t)(32 * (ks - 2) + 8 * gg) * 512;
                    float col[8];
#pragma unroll
                    for (int jx = 0; jx < 8; ++jx) col[jx] = Wt[(size_t)jx * 512 + 64 * hh + 4 * cc + nt];
                    FR[idx] = __builtin_bit_cast(v4u, pack8(col));
                }
            }
            for (int m = gw; m < M_TOK; m += NGW) row_to_bf16_ssq(p.in[0] + (size_t)m * D_MODEL, p.in[1], HN + (size_t)m * D_MODEL, SSP + (size_t)m * 32, lane);
            continue;
        }
        const int l = (ph - 1 - DUP0) / SLOTS, slot = (ph - 1 - DUP0) % SLOTS, sub = (DUP_SUB >= 0 && slot > DUP_SUB) ? slot - 1 : slot;
        const unsigned char* wt = ws + WS_WT + l * WT_LAYER;
        if (sub == 0) {
            for (int st_ = 0; st_ < ((bx >> 3) & 3) * STAGGER_UP; ++st_) __builtin_amdgcn_s_sleep(8);
            pg8::Gemm g{HN, (const bf16*)(wt + WT_IN), M_TOK, IN_W, D_MODEL}; pg8::StaticOrder S; S.init(M_TOK, IN_W, G, bx);
            pg8::EpiBf16<0> E{PROJ, IN_W, SSP};
            pg8::gemm_phase<pg8::EpiBf16<0>, pg8::StaticOrder, true, true>(lds, g, S, E);
            if (G == 256 && bx >= GIN_FULL) conv_job(p, ws, l, 0, CJ_EARLY, (bx - GIN_FULL) * NWAVES + wave, (G - GIN_FULL) * NWAVES, (LAS float*)(lds + wave * 16384), lane);
        } else if (sub == 4) {
            pg8::Gemm g{MIX, (const bf16*)(wt + WT_OUT), M_TOK, D_MODEL, D_MODEL}; pg8::StaticOrder S; S.init(M_TOK, D_MODEL, G, bx);
            if (l == 0) { pg8::EpiRes<0, false, true, false> E{nullptr, p.in[0], D_MODEL, HN, p.in[24], SSPF, nullptr, nullptr};
                pg8::gemm_phase<pg8::EpiRes<0, false, true, false>, pg8::StaticOrder, true, true>(lds, g, S, E); }
            else { pg8::EpiRes<1, false, true, false> E{nullptr, nullptr, D_MODEL, HN, p.in[24] + l * D_MODEL, SSPF, nullptr, p.in[1] + l * D_MODEL};
                pg8::gemm_phase<pg8::EpiRes<1, false, true, false>, pg8::StaticOrder, true, true>(lds, g, S, E); }
        } else if (sub == 5) {
            for (int st_ = 0; st_ < ((bx >> 3) & 3) * STAGGER_UP; ++st_) __builtin_amdgcn_s_sleep(8);
            pg8::Gemm g{HN, (const bf16*)(wt + WT_UP), M_TOK, D_FF, D_MODEL}; pg8::StaticOrder S; S.init(M_TOK, D_FF, G, bx);
            pg8::EpiBf16<1, false> E{HB, D_FF, nullptr};
            pg8::gemm_phase<pg8::EpiBf16<1, false>, pg8::StaticOrder, true, true>(lds, g, S, E);
        } else if (sub == 6) {
            pg8::Gemm g{HB, (const bf16*)(wt + WT_DOWN), M_TOK, D_MODEL, D_FF}; pg8::StaticOrder S; S.init(M_TOK, D_MODEL, G, bx);
            if (l + 1 < DEPTH) { pg8::EpiRes<1, false, true, true> E{nullptr, nullptr, D_MODEL, HN, p.in[1] + (l + 1) * D_MODEL, SSP, SSPF, p.in[24] + l * D_MODEL};
                pg8::gemm_phase<pg8::EpiRes<1, false, true, true>, pg8::StaticOrder, true, true>(lds, g, S, E); }
            else { pg8::EpiRes<1, true, false, true> E{p.out, nullptr, D_MODEL, HN, nullptr, nullptr, SSPF, p.in[24] + l * D_MODEL};
                pg8::gemm_phase<pg8::EpiRes<1, true, false, true>, pg8::StaticOrder, true, true>(lds, g, S, E); }
        }
        else if (sub == 1) {
            RwkvP W;
            W.mu = p.in[9] + l * RW_W; W.w0 = p.in[10] + l * 512; W.w2 = p.in[11] + (size_t)l * 64 * 512; W.a0 = p.in[12] + l * 512; W.a2 = p.in[13] + (size_t)l * 64 * 512;
            W.g2 = p.in[14] + (size_t)l * 128 * 512; W.k_k = p.in[15] + l * 512; W.k_a = p.in[16] + l * 512; W.r_k = p.in[17] + l * 512;
            W.v0 = p.in[20]; W.v1 = p.in[21]; W.v2 = p.in[22]; W.lora = (const v4u*)(ws + WS_LORA) + (size_t)l * 6 * 2048;
            for (int tt = bx; tt < M_TOK / 32; tt += G) prep_tile(lds, tt, tid, PROJ, p.in[3] + l * 3 * 512, W, l, (float*)(ws + WS_SCAN), (float*)((unsigned char*)p.out + OUT_SC2), (float*)(ws + WS_VFIRST), MIX);
        }
        else if (sub == 2) {
            float* scanb = (float*)(ws + WS_SCAN); const size_t SB = (size_t)M_TOK * 512;
            if (bx < N_SCAN_WG) for (int rep_ = 0; rep_ < REP_SCAN; ++rep_) chain_wg(lds, bx, (const unsigned char*)scanb, scanb + 8 * SB, tid);
            else for (int pass = 0; pass < 2; ++pass) {
                if ((((bx - N_SCAN_WG) ^ pass) & 1) == 0) {
                    for (int rep_ = 0; rep_ < REP_ATT; ++rep_) attn_wg(lds, bx - N_SCAN_WG, G - N_SCAN_WG, (G - N_SCAN_WG) % 8 == 0, PROJ, p.in[4] + l * 64, p.in[5] + l * 64, p.in[6] + l * 8, p.in[7] + l * 64, p.in[8] + l * 64, p.in[27], MIX, (bf16*)((unsigned char*)p.out + OUT_DILO), (float*)((unsigned char*)p.out + OUT_DILL), tid);
                    __syncthreads();
                } else {
                    conv_job(p, ws, l, (G == 256) ? CJ_EARLY : 0, CJ_TOTAL + ((l + 1 < DEPTH) ? (D_MODEL / 64) * (IN_W / 32) : 0), (bx - N_SCAN_WG) * NWAVES + wave, (G - N_SCAN_WG) * NWAVES, (LAS float*)(lds + wave * 16384), lane);
                    __syncthreads();
                }
            }
        } else if (sub == 3) {
            float* scanb = (float*)(ws + WS_SCAN); const size_t SB = (size_t)M_TOK * 512;
            for (int m = gw; m < M_TOK; m += NGW) post_token((size_t)m, lane, scanb + 8 * SB, (const bf16*)(scanb + 6 * SB), (const bf16*)(scanb + 5 * SB), (const float*)((unsigned char*)p.out + OUT_SC2), p.in[18] + l * 512, p.in[19] + l * 512, (const bf16*)((unsigned char*)p.out + OUT_DILO), (const float*)((unsigned char*)p.out + OUT_DILL), MIX);
        }
    }
}

static void launch_range(const Params& base, int lo, int hi, int grid, hipStream_t stream) {
    Params p = base; p.ph_lo = lo; p.ph_hi = hi;
    if (hi - lo > 1) { void* args[] = {&p}; hipError_t e = hipLaunchCooperativeKernel((void*)mk_fwd, dim3(grid), dim3(NWAVES * 64), args, LDS_BYTES, stream);
        if (e != hipSuccess) fprintf(stderr, "cooperative launch failed: %s (grid %d)\n", hipGetErrorString(e), grid); }
    else hipLaunchKernelGGL(mk_fwd, dim3(grid), dim3(NWAVES * 64), LDS_BYTES, stream, p);
}
extern "C" void kernel_launch(void* const* d_in, const int* in_sizes, int n_in, void* d_out, int out_size, void* d_ws, size_t ws_size, hipStream_t stream) {
    static int grid = 0;
    if (grid == 0) {
        if (ws_size < WS_END || n_in != 28 || out_size != M_TOK * D_MODEL) { fprintf(stderr, "kernel_launch: unexpected sizes (ws %zu)\n", ws_size); grid = -1; return; }
        int dev = 0, cus = 0, per_cu = 0;
        hipGetDevice(&dev); hipDeviceGetAttribute(&cus, hipDeviceAttributeMultiprocessorCount, dev);
        hipFuncSetAttribute((const void*)mk_fwd, hipFuncAttributeMaxDynamicSharedMemorySize, LDS_BYTES);
        hipOccupancyMaxActiveBlocksPerMultiprocessor(&per_cu, (const void*)mk_fwd, NWAVES * 64, LDS_BYTES);
        if (per_cu < 1) { fprintf(stderr, "kernel_launch: occupancy query says %d blocks per CU\n", per_cu); grid = -1; return; }
        grid = cus;
    }
    if (grid < 0) return;
    Params P{};
    for (int i = 0; i < 28; ++i) P.in[i] = (const float*)d_in[i];
    P.out = (float*)d_out; P.ws = (unsigned char*)d_ws;
    hipMemsetAsync((char*)d_ws + WS_CTL, 0, 65536, stream);
    launch_range(P, 0, N_PHASES, grid, stream);
}
```

```cpp
#include <hip/hip_runtime.h>
#include <cstdio>
#include <cstdint>
#include <cmath>
#ifndef REP_P1
#define REP_P1 1
#define REP_P2 1
#define REP_P3 1
#define REP_P4 1
#endif

constexpr int D_MODEL = 2048, BATCH = 4, SEQ = 2048, DEPTH = 2, HD = 64;
constexpr int M_TOK = BATCH * SEQ;
constexpr int IN_W = 5632, D_FF = 8192;
constexpr int RW_W = 1792;
constexpr int OFF_CB = 0, OFF_CC = 512, OFF_CU = 1024, OFF_SQ = 1536, OFF_SK = 2048, OFF_SV = 2176,
              OFF_DQ = 2304, OFF_DK = 2816, OFF_DV = 3328, OFF_RW = 3840;
constexpr float RMS_EPS = 1e-6f, LN_X_EPS = 64e-5f, NEGF = -1e30f;

typedef unsigned short bf16;
#define GAS __attribute__((address_space(1)))
#define LAS __attribute__((address_space(3)))
typedef unsigned v4u __attribute__((ext_vector_type(4)));
typedef float f32x4 __attribute__((ext_vector_type(4)));
typedef float f32x2 __attribute__((ext_vector_type(2)));
__device__ __forceinline__ unsigned f2bf(float f) { unsigned u = __builtin_bit_cast(unsigned, f); return (u + 0x7fffu + ((u >> 16) & 1u)) >> 16; }
typedef __bf16 bf16n2 __attribute__((ext_vector_type(2)));
__device__ __forceinline__ unsigned pk2(float lo, float hi) { const f32x2 v = {lo, hi}; return __builtin_bit_cast(unsigned, __builtin_convertvector(v, bf16n2)); }
__device__ __forceinline__ float bf2f(unsigned short b) { return __builtin_bit_cast(float, (unsigned)b << 16); }
__device__ __forceinline__ float ldv(const float* p) { return *p; }
__device__ __forceinline__ float ldv(const bf16* p) { return bf2f(*p); }
__device__ __forceinline__ void stv(float* p, float v) { *p = v; }
__device__ __forceinline__ void stv(bf16* p, float v) { *p = (bf16)f2bf(v); }

__device__ __forceinline__ float wave_sum(float v) {
#pragma unroll
    for (int o = 1; o < 64; o <<= 1) v += __shfl_xor(v, o);
    return v;
}
__device__ __forceinline__ float sigmoidf_(float x) { return 1.f / (1.f + expf(-x)); }

__device__ __forceinline__ int t5_bucket(int dist) {
    if (dist < 0) dist = 0;
    if (dist < 16) return dist;
    float scaled = logf((float)dist / 16.f) / logf(8.f);
    int large = 16 + (int)(scaled * 16.f);
    return large < 31 ? large : 31;
}

namespace pg8 {
#define PG8_LAS __attribute__((address_space(3)))
typedef unsigned short bf16_t;
typedef short bf16x8 __attribute__((ext_vector_type(8)));
typedef float f32x4 __attribute__((ext_vector_type(4)));
typedef unsigned u32x4 __attribute__((ext_vector_type(4)));
constexpr int BM = 256, BK = 64, HALF = 128, HTB = HALF * BK * 2  , STAGE_BYTES = 8 * HTB, NXCD = 8, WGM = 8;

__host__ __device__ __forceinline__ int lds_byte(int r, int c) { const int st = (r >> 4) * 2 + (c >> 5), rr = r & 15, cc = c & 31, ob = rr * 64 + cc * 2; return st * 1024 + (ob ^ (((ob >> 9) & 1) << 5)); }
__host__ __device__ __forceinline__ void stage_rc(int b, int& R, int& C) { const int st = b / 1024, sb = b % 1024, swz = sb ^ (((sb >> 9) & 1) << 5); R = (st >> 1) * 16 + swz / 64; C = (st & 1) * 32 + (swz % 64) / 2; }
__host__ __device__ __forceinline__ int perm32(int rho) { const int n = rho >> 4, i = rho & 15; return 8 * (i >> 2) + 4 * n + (i & 3); }

struct Unit { int pm, pn; };
struct Gemm { const bf16_t* A; const bf16_t* Bt; int M, N, K; };

struct StaticOrder {
    int nM, nN, nwg, G, c;
    __host__ __device__ void init(int M, int N, int G_, int c_) { nM = M / BM; nN = N / BM; nwg = nM * nN; G = G_; c = c_; }
    __host__ __device__ bool next(int i, Unit& u) const {
        const long L = (long)i * G + c; if (L >= nwg) return false;
        int wgid = (int)L; { const int q = nwg / NXCD, r = nwg % NXCD, xcd = wgid % NXCD, off = wgid / NXCD; wgid = (xcd < r ? xcd * (q + 1) : r * (q + 1) + (xcd - r) * q) + off; }
        const int nig = WGM * nN, gid = wgid / nig, fm = gid * WGM, gsz = (nM - fm) < WGM ? (nM - fm) : WGM;
        u.pm = fm + ((wgid % nig) % gsz); u.pn = (wgid % nig) / gsz; return true;
    }
    __device__ __forceinline__ void a_ready(const Unit&) const {}
    __device__ __forceinline__ void done(const Unit&) const {}
};

__device__ __forceinline__ unsigned cvt_pk_bf16(float lo, float hi) { return ::pk2(lo, hi); }
typedef float f32x2 __attribute__((ext_vector_type(2)));

template <int ACT  , bool SCALE = true> struct EpiBf16 {
    static constexpr bool PERM = true, AFTER_DRAIN = false;
    bf16_t* O; int ldc; const float* ssp;
    __device__ __forceinline__ void operator()(const f32x4 (&acc)[2][2][4][2], const Unit& u, int wr, int wc, int fr, int fq) const {
        const int row0 = u.pm * BM + wr * 64 + fr, col0 = u.pn * BM + wc * 32 + 8 * fq;
        float rs[2][4];
#pragma unroll
        for (int ai = 0; ai < 2; ++ai)
#pragma unroll
            for (int m = 0; m < 4; ++m) { if (!SCALE) { rs[ai][m] = 1.f; continue; }
                const f32x4* sp = (const f32x4*)(ssp + (size_t)(row0 + ai * HALF + m * 16) * 32 + 8 * fq); const f32x4 a = sp[0], b = sp[1];
                float t = ((a[0] + a[1]) + (a[2] + a[3])) + ((b[0] + b[1]) + (b[2] + b[3]));
                t += __shfl_xor(t, 16); t += __shfl_xor(t, 32);
                const float r = __builtin_amdgcn_rsqf(t * (1.f / 2048.f) + 1e-6f); rs[ai][m] = (ACT == 1) ? r * r : r; }
#pragma unroll
        for (int ai = 0; ai < 2; ++ai)
#pragma unroll
            for (int m = 0; m < 4; ++m) { bf16_t* rowp = O + (size_t)(row0 + ai * HALF + m * 16) * ldc + col0;
#pragma unroll
                for (int bj = 0; bj < 2; ++bj) { f32x4 v0 = acc[ai][bj][m][0], v1 = acc[ai][bj][m][1];
                    if (ACT == 1) { v0 = __builtin_elementwise_max(v0, (f32x4){0.f, 0.f, 0.f, 0.f}); v1 = __builtin_elementwise_max(v1, (f32x4){0.f, 0.f, 0.f, 0.f}); v0 = v0 * v0; v1 = v1 * v1; }
                    if (SCALE) { v0 = v0 * rs[ai][m]; v1 = v1 * rs[ai][m]; }
                    u32x4 w; w.x = cvt_pk_bf16(v0[0], v0[1]); w.y = cvt_pk_bf16(v0[2], v0[3]); w.z = cvt_pk_bf16(v1[0], v1[1]); w.w = cvt_pk_bf16(v1[2], v1[3]);
                    *(u32x4*)(rowp + bj * HALF) = w; } }
    }
};
template <int RMODE, bool WRITEC, bool NORM, bool INSCALE> struct EpiRes {
    static constexpr bool PERM = false, AFTER_DRAIN = false;
    float* C; const float* R; int ldc; bf16_t* HN; const float* gW; float* ssp; const float* ssp_in; const float* gR;
    __device__ __forceinline__ void operator()(const f32x4 (&acc)[2][2][4][2], const Unit& u, int wr, int wc, int fr, int fq) const {
        const int row0 = u.pm * BM + wr * 64 + fr, col0 = u.pn * BM + wc * 32 + 4 * fq;
        f32x4 gv[2][2], gi[2][2];
#pragma unroll
        for (int bj = 0; bj < 2; ++bj)
#pragma unroll
            for (int n = 0; n < 2; ++n) {
                if (NORM) gv[bj][n] = *(const f32x4*)(gW + col0 + bj * HALF + n * 16);
                if (RMODE == 1) { const f32x4 t = *(const f32x4*)(gR + col0 + bj * HALF + n * 16); gi[bj][n] = (f32x4){__builtin_amdgcn_rcpf(t[0]), __builtin_amdgcn_rcpf(t[1]), __builtin_amdgcn_rcpf(t[2]), __builtin_amdgcn_rcpf(t[3])}; } }
#pragma unroll
        for (int ai = 0; ai < 2; ++ai)
#pragma unroll
            for (int m = 0; m < 4; ++m) { const int row = row0 + ai * HALF + m * 16; const size_t off = (size_t)row * ldc + col0; float ssq = 0.f; float sc2 = 1.f;
                if (INSCALE) { const f32x4* sp = (const f32x4*)(ssp_in + (size_t)row * 32 + 8 * fq); const f32x4 a = sp[0], b = sp[1];
                    float t = ((a[0] + a[1]) + (a[2] + a[3])) + ((b[0] + b[1]) + (b[2] + b[3])); t += __shfl_xor(t, 16); t += __shfl_xor(t, 32);
                    const float r = __builtin_amdgcn_rsqf(t * (1.f / 2048.f) + 1e-6f); sc2 = r * r; }
#pragma unroll
                for (int bj = 0; bj < 2; ++bj)
#pragma unroll
                    for (int n = 0; n < 2; ++n) { f32x4 rv;
                        if (RMODE == 0) rv = *(const f32x4*)(R + off + bj * HALF + n * 16);
                        else { const unsigned long long w = *(const unsigned long long*)(HN + off + bj * HALF + n * 16); const unsigned lo = (unsigned)w, hi = (unsigned)(w >> 32);
                            rv = (f32x4){__builtin_bit_cast(float, lo << 16), __builtin_bit_cast(float, lo & 0xffff0000u), __builtin_bit_cast(float, hi << 16), __builtin_bit_cast(float, hi & 0xffff0000u)} * gi[bj][n]; }
                        const f32x4 x = INSCALE ? rv + acc[ai][bj][m][n] * sc2 : rv + acc[ai][bj][m][n];
                        if (WRITEC) *(f32x4*)(C + off + bj * HALF + n * 16) = x;
                        if (NORM) { ssq += (x[0] * x[0] + x[1] * x[1]) + (x[2] * x[2] + x[3] * x[3]); const f32x4 y = x * gv[bj][n];
                            *(unsigned long long*)(HN + off + bj * HALF + n * 16) = (unsigned long long)cvt_pk_bf16(y[0], y[1]) | ((unsigned long long)cvt_pk_bf16(y[2], y[3]) << 32); } }
                if (NORM) { ssq += __shfl_xor(ssq, 16); ssq += __shfl_xor(ssq, 32); if (fq == 0) ssp[(size_t)row * 32 + u.pn * 4 + wc] = ssq; } }
    }
};
template <class Epi, class Sched, bool ALIGN_EPI = false, bool SP2 = false>
__device__ __forceinline__ void gemm_phase(PG8_LAS unsigned char* lds, const Gemm g, const Sched& S, const Epi& E) {
    int tid_o = threadIdx.x; asm volatile("" : "+v"(tid_o));
    const int tid = tid_o, wid = __builtin_amdgcn_readfirstlane(tid >> 6), lane = tid & 63, wr = wid >> 2, wc = wid & 3, fr = lane & 15, fq = lane >> 4;
    const int K = g.K, nt = K / BK;
    unsigned voffA[2], voffB[2];
#pragma unroll
    for (int i = 0; i < 2; ++i) { int R, C; stage_rc(tid * 16 + i * 8192, R, C); const int Rb = Epi::PERM ? ((R & ~31) + perm32(R & 31)) : R;
        voffA[i] = (unsigned)(R * K + C) * 2u; voffB[i] = (unsigned)(Rb * K + C) * 2u; }
    const size_t kstep = (size_t)(BK * 2);
    const size_t hstep = (size_t)HALF * K * 2;
    const size_t tstep = 2 * hstep;
    const unsigned ldsw = (unsigned)wid * 1024u;
    const int aoff = lds_byte(wr * 64 + fr, fq * 8), boff = lds_byte(wc * 32 + fr, fq * 8);
#define PG8_SA(b, h) (((b) * 2 + (h)) * HTB)
#define PG8_SB(b, h) ((4 + (b) * 2 + (h)) * HTB)
#define PG8_STAGE(bufoff, gbase, voff) do { _Pragma("unroll") for (int _i = 0; _i < 2; ++_i) \
        __builtin_amdgcn_global_load_lds((const unsigned*)((const char*)(gbase) + (voff)[_i]), (PG8_LAS unsigned*)(lds + (bufoff) + ldsw + _i * 8192), 16, 0, 0); } while (0)
#define PG8_LDA(dst, b, h) do { _Pragma("unroll") for (int m = 0; m < 4; ++m) _Pragma("unroll") for (int k = 0; k < 2; ++k) dst[m][k] = *(const PG8_LAS bf16x8*)(lds + PG8_SA(b, h) + aoff + m * 2048 + k * 1024); } while (0)
#define PG8_LDB(dst, b, h) do { _Pragma("unroll") for (int n = 0; n < 2; ++n) _Pragma("unroll") for (int k = 0; k < 2; ++k) dst[n][k] = *(const PG8_LAS bf16x8*)(lds + PG8_SB(b, h) + boff + n * 2048 + k * 1024); } while (0)
#define PG8_MMA(ai, bj, At, Bt) do { __builtin_amdgcn_s_setprio(1); _Pragma("unroll") for (int m = 0; m < 4; ++m) _Pragma("unroll") for (int n = 0; n < 2; ++n) _Pragma("unroll") for (int k = 0; k < 2; ++k) \
        acc[ai][bj][m][n] = __builtin_amdgcn_mfma_f32_16x16x32_bf16(Bt[n][k], At[m][k], acc[ai][bj][m][n], 0, 0, 0); __builtin_amdgcn_s_setprio(0); } while (0)
#define PG8_WAIT_V(n) asm volatile("s_waitcnt vmcnt(" #n ")" ::: "memory")
#define PG8_WAIT_L(n) asm volatile("s_waitcnt lgkmcnt(" #n ")" ::: "memory")
#define PG8_BAR __builtin_amdgcn_s_barrier()
#define PG8_SCHED __builtin_amdgcn_sched_barrier(0)
    Unit cur, nxt; int ui = 0;
    if (!S.next(0, cur)) return;
    f32x4 acc[2][2][4][2];
#pragma unroll
    for (int a = 0; a < 2; ++a)
#pragma unroll
        for (int b = 0; b < 2; ++b)
#pragma unroll
            for (int m = 0; m < 4; ++m)
#pragma unroll
                for (int n = 0; n < 2; ++n) acc[a][b][m][n] = (f32x4){0.f, 0.f, 0.f, 0.f};
    bf16x8 At[4][2], B0[2][2], B1[2][2];
    const char* cA = (const char*)g.A + (size_t)cur.pm * tstep; const char* cB = (const char*)g.Bt + (size_t)cur.pn * tstep;
    S.a_ready(cur);
    if constexpr (SP2) {
        PG8_STAGE(PG8_SB(0, 0), cB, voffB); PG8_STAGE(PG8_SB(0, 1), cB + hstep, voffB); PG8_STAGE(PG8_SA(0, 0), cA, voffA); PG8_STAGE(PG8_SA(0, 1), cA + hstep, voffA);
        if (wr == 1) PG8_BAR;
        PG8_WAIT_V(2); PG8_BAR;
        PG8_STAGE(PG8_SB(1, 0), cB + kstep, voffB); PG8_STAGE(PG8_SA(1, 0), cA + kstep, voffA); PG8_STAGE(PG8_SB(1, 1), cB + hstep + kstep, voffB);
        PG8_WAIT_V(6); PG8_BAR;
    } else {
        PG8_STAGE(PG8_SB(0, 0), cB, voffB); PG8_STAGE(PG8_SA(0, 0), cA, voffA); PG8_STAGE(PG8_SB(0, 1), cB + hstep, voffB); PG8_STAGE(PG8_SA(0, 1), cA + hstep, voffA);
        if (wr == 1) PG8_BAR;
        PG8_WAIT_V(4); PG8_BAR;
        PG8_STAGE(PG8_SB(1, 0), cB + kstep, voffB); PG8_STAGE(PG8_SA(1, 0), cA + kstep, voffA); PG8_STAGE(PG8_SB(1, 1), cB + hstep + kstep, voffB);
        PG8_WAIT_V(6); PG8_BAR;
    }
    for (;;) {
        const bool has_next = S.next(ui + 1, nxt);
        const char* nA = has_next ? (const char*)g.A + (size_t)nxt.pm * tstep : cA; const char* nB = has_next ? (const char*)g.Bt + (size_t)nxt.pn * tstep : cB;
        for (int t = 0; t < nt; t += 2) {
            const bool last = (t == nt - 2);
            const char* a1 = cA + (size_t)(t + 1) * kstep;
            const char* a2 = last ? nA : cA + (size_t)(t + 2) * kstep; const char* b2 = last ? nB : cB + (size_t)(t + 2) * kstep;
            const char* a3 = a2 + kstep; const char* b3 = b2 + kstep;
            if (last && has_next) S.a_ready(nxt);
            if constexpr (SP2) {
            PG8_LDB(B0, 0, 0); PG8_LDB(B1, 0, 1); PG8_SCHED; PG8_LDA(At, 0, 0); PG8_STAGE(PG8_SA(1, 1), a1 + hstep, voffA);
            PG8_WAIT_V(8); PG8_WAIT_L(0); PG8_BAR; PG8_MMA(0, 0, At, B0); PG8_MMA(0, 1, At, B1); PG8_BAR; PG8_SCHED;
            PG8_LDA(At, 0, 1); PG8_STAGE(PG8_SB(0, 0), b2, voffB); PG8_STAGE(PG8_SB(0, 1), b2 + hstep, voffB); PG8_STAGE(PG8_SA(0, 0), a2, voffA);
            PG8_WAIT_V(8); PG8_WAIT_L(0); PG8_BAR; PG8_MMA(1, 0, At, B0); PG8_MMA(1, 1, At, B1); PG8_BAR; PG8_SCHED;
            PG8_LDB(B0, 1, 0); PG8_LDB(B1, 1, 1); PG8_SCHED; PG8_LDA(At, 1, 0); PG8_STAGE(PG8_SA(0, 1), a2 + hstep, voffA);
            PG8_WAIT_V(8); PG8_WAIT_L(0); PG8_BAR; PG8_MMA(0, 0, At, B0); PG8_MMA(0, 1, At, B1); PG8_BAR; PG8_SCHED;
            PG8_LDA(At, 1, 1); PG8_STAGE(PG8_SB(1, 0), b3, voffB); PG8_STAGE(PG8_SB(1, 1), b3 + hstep, voffB); PG8_STAGE(PG8_SA(1, 0), a3, voffA);
            PG8_WAIT_V(8); PG8_WAIT_L(0); PG8_BAR; PG8_MMA(1, 0, At, B0); PG8_MMA(1, 1, At, B1); PG8_BAR; PG8_SCHED;
            } else {
            PG8_LDB(B0, 0, 0); PG8_SCHED; PG8_LDA(At, 0, 0); PG8_STAGE(PG8_SA(1, 1), a1 + hstep, voffA);
            PG8_WAIT_L(8); PG8_BAR; PG8_WAIT_L(0); PG8_MMA(0, 0, At, B0); PG8_BAR; PG8_SCHED;
            PG8_LDB(B1, 0, 1); PG8_STAGE(PG8_SB(0, 0), b2, voffB);
            PG8_BAR; PG8_WAIT_L(0); PG8_MMA(0, 1, At, B1); PG8_BAR;
            PG8_LDA(At, 0, 1); PG8_STAGE(PG8_SA(0, 0), a2, voffA);
            PG8_BAR; PG8_WAIT_L(0); PG8_MMA(1, 0, At, B0); PG8_BAR; PG8_SCHED;
            PG8_STAGE(PG8_SB(0, 1), b2 + hstep, voffB);
            PG8_WAIT_V(6); PG8_BAR; PG8_MMA(1, 1, At, B1); PG8_BAR;
            PG8_LDB(B0, 1, 0); PG8_SCHED; PG8_LDA(At, 1, 0); PG8_STAGE(PG8_SA(0, 1), a2 + hstep, voffA);
            PG8_WAIT_L(8); PG8_BAR; PG8_WAIT_L(0); PG8_MMA(0, 0, At, B0); PG8_BAR; PG8_SCHED;
            PG8_LDB(B1, 1, 1); PG8_STAGE(PG8_SB(1, 0), b3, voffB);
            PG8_BAR; PG8_WAIT_L(0); PG8_MMA(0, 1, At, B1); PG8_BAR;
            PG8_LDA(At, 1, 1); PG8_STAGE(PG8_SA(1, 0), a3, voffA);
            PG8_BAR; PG8_WAIT_L(0); PG8_MMA(1, 0, At, B0); PG8_BAR; PG8_SCHED;
            PG8_STAGE(PG8_SB(1, 1), b3 + hstep, voffB);
            PG8_WAIT_V(6); PG8_BAR; PG8_MMA(1, 1, At, B1); PG8_BAR;
            }
        }
        if constexpr (ALIGN_EPI) { if (wr == 0) PG8_BAR; }
        if constexpr (!Epi::AFTER_DRAIN) { E(acc, cur, wr, wc, fr, fq); S.done(cur); }
        if (!has_next) break;
#pragma unroll
        for (int a = 0; a < 2; ++a)
#pragma unroll
            for (int b = 0; b < 2; ++b)
#pragma unroll
                for (int m = 0; m < 4; ++m)
#pragma unroll
                    for (int n = 0; n < 2; ++n) acc[a][b][m][n] = (f32x4){0.f, 0.f, 0.f, 0.f};
        cur = nxt; cA = nA; cB = nB; ++ui;
        if constexpr (ALIGN_EPI) { if (wr == 1) PG8_BAR; }
    }
    PG8_WAIT_V(0);
    if constexpr (!ALIGN_EPI) { if (wr == 0) PG8_BAR; }
    PG8_BAR;
    if constexpr (Epi::AFTER_DRAIN) { E.fused(acc, cur, wr, wc, fr, fq, lds, wid, lane); S.done(cur); }
#undef PG8_SA
#undef PG8_SB
#undef PG8_STAGE
#undef PG8_LDA
#undef PG8_LDB
#undef PG8_MMA
#undef PG8_WAIT_V
#undef PG8_WAIT_L
#undef PG8_BAR
#undef PG8_SCHED
}
}

typedef short bf16x8_t __attribute__((ext_vector_type(8)));
typedef short s16x4_t __attribute__((ext_vector_type(4)));
template <int CTRL> __device__ __forceinline__ float dpp_f(float x) { return __builtin_bit_cast(float, __builtin_amdgcn_mov_dpp(__builtin_bit_cast(int, x), CTRL, 0xF, 0xF, true)); }
__device__ __forceinline__ float allreduce16(float p) {
    p += dpp_f<0xB1>(p);
    p += dpp_f<0x4E>(p);
    p += dpp_f<0x141>(p);
    p += dpp_f<0x140>(p);
    return p;
}
__device__ __forceinline__ float allreduce8(float p) { p += dpp_f<0xB1>(p); p += dpp_f<0x4E>(p); p += dpp_f<0x141>(p); return p; }

constexpr int AT_K = 0, AT_V = 65536, AT_TB = 131072, AT_G = AT_TB + 6400, AT_RB = AT_G + 1024, AT_SK = AT_RB + 2048, AT_END = AT_SK + 32;
constexpr int N_ATT_UNITS = 2048;
__device__ __forceinline__ int k_off(int key, int chunk) { return key * 128 + ((chunk ^ ((key >> 1) & 7)) << 4); }
__device__ __forceinline__ int v_off(int key, int chunk) { return key * 128 + ((chunk ^ (((key >> 1) & 3) << 1)) << 4); }
__device__ __forceinline__ unsigned cvtpk(float lo, float hi) { const f32x2 v = {lo, hi}; return __builtin_bit_cast(unsigned, __builtin_convertvector(v, bf16n2)); }
struct AttU { int type, b, h, r, c, j; };
__device__ __forceinline__ AttU att_decode(int u) {
    AttU a; const int ux = u >> 8, uy = u & 255, jj = uy & 15; a.type = uy >> 6; a.b = ux >> 1; a.h = (ux & 1) * 4 + ((uy >> 4) & 3);
    if (a.type <= 1) { a.r = 1; a.c = 0; a.j = jj; } else if (a.type == 2) { a.r = 4; a.c = jj & 3; a.j = jj >> 2; } else { a.r = 16; a.c = jj; a.j = 0; }
    return a;
}
__device__ __forceinline__ void att_issue(LAS unsigned char* lds, int buf, const AttU& a, const bf16* __restrict__ PROJ, int wave, int lane) {
    const int kcol = a.type == 0 ? OFF_SK + 64 * (a.h >> 2) : OFF_DK + 64 * a.h, vcol = a.type == 0 ? OFF_SV + 64 * (a.h >> 2) : OFF_DV + 64 * a.h;
#pragma unroll
    for (int i = 0; i < 4; ++i) {
        const int key = 8 * (4 * wave + i) + (lane >> 3), cp = lane & 7;
        int li = 128 * (a.j - 1) + key; li = li < 0 ? 0 : li;
        const bf16* rowp = PROJ + ((size_t)a.b * SEQ + a.c + a.r * li) * IN_W;
        __builtin_amdgcn_global_load_lds((const unsigned*)(rowp + kcol + 8 * (cp ^ ((key >> 1) & 7))), (LAS unsigned*)(lds + AT_K + buf * 32768 + (4 * wave + i) * 1024), 16, 0, 0);
        __builtin_amdgcn_global_load_lds((const unsigned*)(rowp + vcol + 8 * (cp ^ (((key >> 1) & 3) << 1))), (LAS unsigned*)(lds + AT_V + buf * 32768 + (4 * wave + i) * 1024), 16, 0, 0);
    }
}
__device__ __forceinline__ void att_loadq(const AttU& a, const bf16* __restrict__ PROJ, int wave, int g, int cc, v4u& q0, v4u& q1) {
    const int qcol = a.type == 0 ? OFF_SQ + 64 * a.h : OFF_DQ + 64 * a.h;
    const bf16* qp = PROJ + ((size_t)a.b * SEQ + a.c + a.r * (128 * a.j + 16 * wave + cc)) * IN_W + qcol + 8 * g;
    q0 = *(const v4u*)qp; q1 = *(const v4u*)(qp + 32);
}
__device__ __forceinline__ void att_normq(LAS unsigned char* lds, const AttU& a, int g, const v4u q0, const v4u q1, bf16x8_t (&qf)[2]) {
    float qv[16]; float ss = 0.f;
#pragma unroll
    for (int e = 0; e < 4; ++e) { qv[2 * e] = __builtin_bit_cast(float, q0[e] << 16); qv[2 * e + 1] = __builtin_bit_cast(float, q0[e] & 0xffff0000u); qv[8 + 2 * e] = __builtin_bit_cast(float, q1[e] << 16); qv[8 + 2 * e + 1] = __builtin_bit_cast(float, q1[e] & 0xffff0000u); }
#pragma unroll
    for (int e = 0; e < 16; ++e) ss += qv[e] * qv[e];
    ss += __shfl_xor(ss, 16); ss += __shfl_xor(ss, 32);
    const float rs = rsqrtf(ss * (1.f / 64.f) + RMS_EPS) * 0.125f;
    const LAS float* qg = (const LAS float*)(lds + AT_G) + (a.type == 0 ? 0 : 128);
    const f32x4 ga = *(const LAS f32x4*)(qg + 8 * g), gb = *(const LAS f32x4*)(qg + 8 * g + 4), gc = *(const LAS f32x4*)(qg + 32 + 8 * g), gd = *(const LAS f32x4*)(qg + 32 + 8 * g + 4);
    v4u x, y;
    x.x = cvtpk(qv[0] * rs * ga.x, qv[1] * rs * ga.y); x.y = cvtpk(qv[2] * rs * ga.z, qv[3] * rs * ga.w); x.z = cvtpk(qv[4] * rs * gb.x, qv[5] * rs * gb.y); x.w = cvtpk(qv[6] * rs * gb.z, qv[7] * rs * gb.w);
    y.x = cvtpk(qv[8] * rs * gc.x, qv[9] * rs * gc.y); y.y = cvtpk(qv[10] * rs * gc.z, qv[11] * rs * gc.w); y.z = cvtpk(qv[12] * rs * gd.x, qv[13] * rs * gd.y); y.w = cvtpk(qv[14] * rs * gd.z, qv[15] * rs * gd.w);
    qf[0] = __builtin_bit_cast(bf16x8_t, x); qf[1] = __builtin_bit_cast(bf16x8_t, y);
}
#define ATT_LBAR asm volatile("s_waitcnt lgkmcnt(0)\n\ts_barrier" ::: "memory")
__device__ __forceinline__ void attn_wg(LAS unsigned char* lds, int v0, int vstride, bool xmap, const bf16* __restrict__ PROJ, const float* __restrict__ qg_swa, const float* __restrict__ kg_swa, const float* __restrict__ sink_swa,
                                        const float* __restrict__ qg_dil, const float* __restrict__ kg_dil, const float* __restrict__ rel_bias, bf16* __restrict__ MIX, bf16* __restrict__ DILO, float* __restrict__ DILL, int tid) {
    if (v0 >= N_ATT_UNITS) return;
    const int wave = __builtin_amdgcn_readfirstlane(tid >> 6), lane = tid & 63, g = lane >> 4, cc = lane & 15;
    if (tid < 256) { const int w = tid >> 6, e = tid & 63; ((LAS float*)(lds + AT_G))[tid] = (w == 0 ? qg_swa : w == 1 ? kg_swa : w == 2 ? qg_dil : kg_dil)[e]; }
    ((LAS float*)(lds + AT_RB))[tid] = rel_bias[tid];
    if (tid < 8) ((LAS float*)(lds + AT_SK))[tid] = sink_swa[tid];
    AttU a = att_decode(xmap ? (v0 & 7) * 256 + (v0 >> 3) : v0);
    att_issue(lds, 0, a, PROJ, wave, lane);
    bf16x8_t qf[2];
    { v4u q0, q1; att_loadq(a, PROJ, wave, g, cc, q0, q1); asm volatile("s_waitcnt vmcnt(0)" ::: "memory"); ATT_LBAR; att_normq(lds, a, g, q0, q1, qf); }
    int buf = 0;
    for (int v = v0; v < N_ATT_UNITS; v += vstride, buf ^= 1) {
        const bool swa = (a.type == 0);
        const int maxd = swa ? 127 : 128, bc = swa ? a.h : 8 + a.h;
        LAS unsigned char* const KB = lds + AT_K + buf * 32768; LAS unsigned char* const VB = lds + AT_V + buf * 32768;
        {
            const int x = tid >> 1, hr = tid & 1;
            v4u kr[4];
#pragma unroll
            for (int ch = 0; ch < 4; ++ch) kr[ch] = *(const LAS v4u*)(KB + k_off(x, 4 * hr + ch));
            float kf[32]; float ss = 0.f;
#pragma unroll
            for (int ch = 0; ch < 4; ++ch)
#pragma unroll
                for (int e = 0; e < 4; ++e) { const unsigned wv = kr[ch][e]; const float lo = __builtin_bit_cast(float, wv << 16), hi = __builtin_bit_cast(float, wv & 0xffff0000u); kf[ch * 8 + 2 * e] = lo; kf[ch * 8 + 2 * e + 1] = hi; ss += lo * lo + hi * hi; }
            ss += __shfl_xor(ss, 1);
            const float rs = rsqrtf(ss * (1.f / 64.f) + RMS_EPS);
            const LAS float* kg = (const LAS float*)(lds + AT_G) + (swa ? 64 : 192);
#pragma unroll
            for (int ch = 0; ch < 4; ++ch) {
                const f32x4 g0 = *(const LAS f32x4*)(kg + 32 * hr + 8 * ch), g1 = *(const LAS f32x4*)(kg + 32 * hr + 8 * ch + 4);
                v4u o; o.x = cvtpk(kf[ch * 8 + 0] * rs * g0.x, kf[ch * 8 + 1] * rs * g0.y); o.y = cvtpk(kf[ch * 8 + 2] * rs * g0.z, kf[ch * 8 + 3] * rs * g0.w);
                o.z = cvtpk(kf[ch * 8 + 4] * rs * g1.x, kf[ch * 8 + 5] * rs * g1.y); o.w = cvtpk(kf[ch * 8 + 6] * rs * g1.z, kf[ch * 8 + 7] * rs * g1.w);
                *(LAS v4u*)(KB + k_off(x, 4 * hr + ch)) = o;
            }
            if (tid < 384) { const int dist = 255 - tid; float val = NEGF; if (dist >= 0 && dist <= maxd) val = ((const LAS float*)(lds + AT_RB))[t5_bucket(dist * a.r) * 16 + bc];
#pragma unroll
                for (int sft = 0; sft < 4; ++sft) if (tid >= sft) ((LAS float*)(lds + AT_TB))[sft * 400 + tid - sft] = val; }
        }
        ATT_LBAR;
        const int vn = v + vstride; const bool more = vn < N_ATT_UNITS;
        AttU an = a; v4u qn0 = (v4u){0u, 0u, 0u, 0u}, qn1 = qn0;
        if (more) { an = att_decode(xmap ? (vn & 7) * 256 + (vn >> 3) : vn); att_issue(lds, buf ^ 1, an, PROJ, wave, lane); att_loadq(an, PROJ, wave, g, cc, qn0, qn1); }
        const int n0 = wave & ~1;
        f32x4 sc[10];
        {
            bf16x8_t kfa[10], kfb[10];
#pragma unroll
            for (int nn = 0; nn < 10; ++nn) { const int key = 16 * (n0 + nn) + cc; kfa[nn] = *(const LAS bf16x8_t*)(KB + k_off(key, g)); kfb[nn] = *(const LAS bf16x8_t*)(KB + k_off(key, g + 4)); }
            __builtin_amdgcn_sched_barrier(0);
#pragma unroll
            for (int nn = 0; nn < 10; ++nn) {
                f32x4 acc = (f32x4){0.f, 0.f, 0.f, 0.f};
                acc = __builtin_amdgcn_mfma_f32_16x16x32_bf16(kfa[nn], qf[0], acc, 0, 0, 0);
                acc = __builtin_amdgcn_mfma_f32_16x16x32_bf16(kfb[nn], qf[1], acc, 0, 0, 0);
                sc[nn] = acc;
            }
        }
        const int ib = 4 * g - 16 * wave - cc + 127;
        const LAS float* tb = (const LAS float*)(lds + AT_TB) + (ib & 3) * 400 + (ib & ~3) + 16 * n0;
        const float sink = swa ? ((const LAS float*)(lds + AT_SK))[a.h] : NEGF;
        f32x4 bv[10];
#pragma unroll
        for (int nn = 0; nn < 10; ++nn) bv[nn] = *(const LAS f32x4*)(tb + 16 * nn);
        float m = NEGF;
#pragma unroll
        for (int nn = 0; nn < 10; ++nn) {
            const int n = n0 + nn;
#pragma unroll
            for (int i = 0; i < 4; ++i) { float sv = sc[nn][i] + bv[nn][i]; if (a.j == 0 && n < 8) sv = NEGF; sc[nn][i] = sv; m = fmaxf(m, sv); }
        }
        m = fmaxf(m, __shfl_xor(m, 16)); m = fmaxf(m, __shfl_xor(m, 32));
        m = fmaxf(m, sink);
        float l = 0.f;
#pragma unroll
        for (int nn = 0; nn < 10; ++nn)
#pragma unroll
            for (int i = 0; i < 4; ++i) { const float pv = __expf(sc[nn][i] - m); sc[nn][i] = pv; l += pv; }
        l += __shfl_xor(l, 16); l += __shfl_xor(l, 32);
        l += __expf(sink - m);
        f32x4 oa[4];
#pragma unroll
        for (int m4 = 0; m4 < 4; ++m4) oa[m4] = (f32x4){0.f, 0.f, 0.f, 0.f};
        const int tq_ = (cc >> 2), tp_ = cc & 3;
#pragma unroll
        for (int pp = 0; pp < 5; ++pp) {
            v4u pw; pw.x = cvtpk(sc[2 * pp][0], sc[2 * pp][1]); pw.y = cvtpk(sc[2 * pp][2], sc[2 * pp][3]); pw.z = cvtpk(sc[2 * pp + 1][0], sc[2 * pp + 1][1]); pw.w = cvtpk(sc[2 * pp + 1][2], sc[2 * pp + 1][3]);
            const bf16x8_t pf = __builtin_bit_cast(bf16x8_t, pw);
            const int kb0 = 16 * (n0 + 2 * pp) + 4 * g + tq_, kb1 = kb0 + 16;
#pragma unroll
            for (int m4 = 0; m4 < 4; ++m4) {
                const s16x4_t lo = __builtin_bit_cast(s16x4_t, __builtin_amdgcn_ds_read_tr16_b64_v4i16((LAS s16x4_t*)(VB + v_off(kb0, 2 * m4 + (tp_ >> 1)) + (tp_ & 1) * 8)));
                const s16x4_t hi = __builtin_bit_cast(s16x4_t, __builtin_amdgcn_ds_read_tr16_b64_v4i16((LAS s16x4_t*)(VB + v_off(kb1, 2 * m4 + (tp_ >> 1)) + (tp_ & 1) * 8)));
                const bf16x8_t vf = (bf16x8_t){lo[0], lo[1], lo[2], lo[3], hi[0], hi[1], hi[2], hi[3]};
                oa[m4] = __builtin_amdgcn_mfma_f32_16x16x32_bf16(vf, pf, oa[m4], 0, 0, 0);
            }
        }
        asm volatile("s_waitcnt vmcnt(0)" ::: "memory");
        bf16x8_t qfn[2] = {qf[0], qf[1]};
        if (more) att_normq(lds, an, g, qn0, qn1, qfn);
        const float inv = 1.f / l;
        const size_t tok = (size_t)a.b * SEQ + a.c + a.r * (128 * a.j + 16 * wave + cc);
#pragma unroll
        for (int m4 = 0; m4 < 4; ++m4) {
            const unsigned w0 = cvtpk(oa[m4][0] * inv, oa[m4][1] * inv), w1 = cvtpk(oa[m4][2] * inv, oa[m4][3] * inv);
            const unsigned long long pk = (unsigned long long)w0 | ((unsigned long long)w1 << 32);
            const int d = 16 * m4 + 4 * g;
            if (swa) *(unsigned long long*)(MIX + tok * D_MODEL + 512 + 64 * a.h + d) = pk;
            else *(unsigned long long*)(DILO + ((size_t)(a.type - 1) * M_TOK + tok) * 512 + 64 * a.h + d) = pk;
        }
        if (!swa && g == 0) DILL[((size_t)(a.type - 1) * M_TOK + tok) * 8 + a.h] = m + __logf(l);
        ATT_LBAR;
        a = an; qf[0] = qfn[0]; qf[1] = qfn[1];
    }
}

__device__ __forceinline__ void unpack8(const v4u w, float (&o)[8]) {
#pragma unroll
    for (int e = 0; e < 4; ++e) { o[2 * e] = __builtin_bit_cast(float, w[e] << 16); o[2 * e + 1] = __builtin_bit_cast(float, w[e] & 0xffff0000u); }
}
__device__ __forceinline__ void unpack4(const unsigned long long w, float (&o)[4]) {
    const unsigned lo = (unsigned)w, hi = (unsigned)(w >> 32);
    o[0] = __builtin_bit_cast(float, lo << 16); o[1] = __builtin_bit_cast(float, lo & 0xffff0000u); o[2] = __builtin_bit_cast(float, hi << 16); o[3] = __builtin_bit_cast(float, hi & 0xffff0000u);
}
__device__ __forceinline__ void post_token(size_t tok, int lane, const float* __restrict__ Yb, const bf16* __restrict__ Gb, const bf16* __restrict__ Vb, const float* __restrict__ SC2, const float* __restrict__ ln_g, const float* __restrict__ ln_b,
                                           const bf16* __restrict__ DILO, const float* __restrict__ DILL, bf16* __restrict__ MIX) {
    const int c8 = 8 * lane, hh = lane >> 3;
    {
        const f32x4 y0 = *(const f32x4*)(Yb + tok * 512 + c8), y1 = *(const f32x4*)(Yb + tok * 512 + c8 + 4);
        float y[8] = {y0.x, y0.y, y0.z, y0.w, y1.x, y1.y, y1.z, y1.w};
        float sm = 0.f;
#pragma unroll
        for (int e = 0; e < 8; ++e) sm += y[e];
        const float mean = allreduce8(sm) * (1.f / 64.f);
        float sq = 0.f;
#pragma unroll
        for (int e = 0; e < 8; ++e) { y[e] -= mean; sq += y[e] * y[e]; }
        const float rstd = rsqrtf(allreduce8(sq) * (1.f / 64.f) + LN_X_EPS);
        float gg[8]; unpack8(*(const v4u*)(Gb + tok * 512 + c8), gg);
        const float bsc = SC2[(tok * 8 + hh) * 4 + 2];
        float vv8[8]; unpack8(*(const v4u*)(Vb + tok * 512 + c8), vv8);
        const f32x4 lg0 = *(const f32x4*)(ln_g + c8), lg1 = *(const f32x4*)(ln_g + c8 + 4), lb0 = *(const f32x4*)(ln_b + c8), lb1 = *(const f32x4*)(ln_b + c8 + 4);
        const float bb[8] = {vv8[0] * bsc, vv8[1] * bsc, vv8[2] * bsc, vv8[3] * bsc, vv8[4] * bsc, vv8[5] * bsc, vv8[6] * bsc, vv8[7] * bsc};
        const float lg[8] = {lg0.x, lg0.y, lg0.z, lg0.w, lg1.x, lg1.y, lg1.z, lg1.w}, lb[8] = {lb0.x, lb0.y, lb0.z, lb0.w, lb1.x, lb1.y, lb1.z, lb1.w};
        float o[8];
#pragma unroll
        for (int e = 0; e < 8; ++e) o[e] = (y[e] * rstd * lg[e] + lb[e] + bb[e]) * gg[e];
        v4u w; w.x = pk2(o[0], o[1]); w.y = pk2(o[2], o[3]); w.z = pk2(o[4], o[5]); w.w = pk2(o[6], o[7]);
        *(v4u*)(MIX + tok * D_MODEL + 1536 + c8) = w;
    }
    {
        const float l0 = DILL[((size_t)0 * M_TOK + tok) * 8 + hh], l1 = DILL[((size_t)1 * M_TOK + tok) * 8 + hh], l2 = DILL[((size_t)2 * M_TOK + tok) * 8 + hh];
        const float mx = fmaxf(l0, fmaxf(l1, l2));
        float w0 = __expf(l0 - mx), w1 = __expf(l1 - mx), w2 = __expf(l2 - mx);
        const float inv = 1.f / (w0 + w1 + w2); w0 *= inv; w1 *= inv; w2 *= inv;
        const v4u a = *(const v4u*)(DILO + ((size_t)0 * M_TOK + tok) * 512 + c8), bq = *(const v4u*)(DILO + ((size_t)1 * M_TOK + tok) * 512 + c8), cq = *(const v4u*)(DILO + ((size_t)2 * M_TOK + tok) * 512 + c8);
        v4u w;
#pragma unroll
        for (int e = 0; e < 4; ++e) {
            const float lo = w0 * __builtin_bit_cast(float, a[e] << 16) + w1 * __builtin_bit_cast(float, bq[e] << 16) + w2 * __builtin_bit_cast(float, cq[e] << 16);
            const float hi = w0 * __builtin_bit_cast(float, a[e] & 0xffff0000u) + w1 * __builtin_bit_cast(float, bq[e] & 0xffff0000u) + w2 * __builtin_bit_cast(float, cq[e] & 0xffff0000u);
            w[e] = pk2(lo, hi);
        }
        *(v4u*)(MIX + tok * D_MODEL + 1024 + c8) = w;
    }
}

constexpr int RC_AT = 0;
constexpr int RC_RT = 2304;
constexpr int RC_BKT = 4608;
constexpr int RC_VT = 9728;
constexpr int RC_GT = 12800;
constexpr int RC_MT = 14080;
constexpr int RC_NT = 14848;
constexpr int RC_GAM = 15872;
constexpr int RC_BYTES = 16128;
constexpr int RG_AT = 0, RG_RT = 2048, RG_BKT = 4096, RG_VT = 8192, RG_GT = 10240, RG_MT = 11264, RG_NT = 11776, RG_GAM = 12800, RG_BYTES = 13056, RC_PIECES = RG_BYTES / 16;
constexpr int CH_NIMG = 4;
constexpr int CH_RING = 8;
__device__ __forceinline__ int chain_dst(int pc) {
    if (pc < RG_RT / 16)  { return RC_AT + (pc >> 3) * 144 + (pc & 7) * 16; }
    if (pc < RG_BKT / 16) { const int q = pc - RG_RT / 16;  return RC_RT + (q >> 3) * 144 + (q & 7) * 16; }
    if (pc < RG_VT / 16)  { const int q = pc - RG_BKT / 16; return RC_BKT + (q >> 2) * 80 + (q & 3) * 16; }
    if (pc < RG_GT / 16)  { const int q = pc - RG_VT / 16;  return RC_VT + (q >> 1) * 48 + (q & 1) * 16; }
    if (pc < RG_MT / 16)  { const int q = pc - RG_GT / 16;  return RC_GT + (q >> 2) * 80 + (q & 3) * 16; }
    if (pc < RG_NT / 16)  { const int q = pc - RG_MT / 16;  return RC_MT + (q >> 1) * 48 + (q & 1) * 16; }
    if (pc < RG_GAM / 16) { return RC_NT + (pc - RG_NT / 16) * 16; }
    return RC_GAM + (pc - RG_GAM / 16) * 16;
}
__device__ __forceinline__ bf16x8_t frag2(const LAS unsigned char* p, int second) {
    const unsigned long long lo = *(const LAS unsigned long long*)p, hi = *(const LAS unsigned long long*)(p + second);
    v4u w; w.x = (unsigned)lo; w.y = (unsigned)(lo >> 32); w.z = (unsigned)hi; w.w = (unsigned)(hi >> 32); return __builtin_bit_cast(bf16x8_t, w);
}
#define CHAIN_LBAR do { asm volatile("" ::: "memory"); __builtin_amdgcn_s_waitcnt(0xC07F); __builtin_amdgcn_s_barrier(); asm volatile("" ::: "memory"); } while (0)
__device__ __forceinline__ void chain_wg(LAS unsigned char* lds, int hb, const unsigned char* __restrict__ REC, float* __restrict__ Yb, int tid) {
    asm volatile("" : "+v"(tid));
    const int b = hb >> 3, h = hb & 7;
    const int wave = __builtin_amdgcn_readfirstlane(tid >> 6), lane = tid & 63, g = lane >> 4, c = lane & 15;
    constexpr int NCK = SEQ / 16;
    const unsigned char* rec0 = REC + ((size_t)(b * NCK) * 8 + h) * RG_BYTES;
    const size_t recstep = (size_t)8 * RG_BYTES;
    if (wave >= 4) {
        const int lt = tid - 256;
        int pg[4], pd[4];
#pragma unroll
        for (int k = 0; k < 4; ++k) { int pc = lt + 256 * k; pc = pc < RC_PIECES ? pc : RC_PIECES - 1; pg[k] = pc * 16; pd[k] = chain_dst(pc); }
        v4u L[CH_RING][4];
#pragma unroll
        for (int s = 0; s < CH_RING; ++s)
#pragma unroll
            for (int k = 0; k < 4; ++k) L[s][k] = *(const v4u*)(rec0 + (size_t)s * recstep + pg[k]);
#pragma unroll
        for (int s = 0; s < 2; ++s) {
#pragma unroll
            for (int k = 0; k < 4; ++k) *(LAS v4u*)(lds + s * RC_BYTES + pd[k]) = L[s][k];
#pragma unroll
            for (int k = 0; k < 4; ++k) L[s][k] = *(const v4u*)(rec0 + (size_t)(CH_RING + s) * recstep + pg[k]);
        }
        if (lt < 16) ((LAS unsigned*)(lds + (lt >> 2) * RC_BYTES + RC_AT + 128))[lt & 3] = 0u;
        CHAIN_LBAR;
#pragma unroll 1
        for (int ck = 0; ck < NCK; ck += CH_RING) {
#pragma unroll
            for (int q = 0; q < CH_RING; ++q) {
                const int cc = ck + q, s = (q + 2) % CH_RING, img = ((q + 2) % CH_NIMG) * RC_BYTES;
#pragma unroll
                for (int k = 0; k < 4; ++k) *(LAS v4u*)(lds + img + pd[k]) = L[s][k];
                const int nx = (cc + 2 + CH_RING < NCK) ? cc + 2 + CH_RING : NCK - 1;
#pragma unroll
                for (int k = 0; k < 4; ++k) L[s][k] = *(const v4u*)(rec0 + (size_t)nx * recstep + pg[k]);
                CHAIN_LBAR;
            }
        }
    } else {
        f32x4 ST[4];
#pragma unroll
        for (int kt = 0; kt < 4; ++kt) ST[kt] = (f32x4){0.f, 0.f, 0.f, 0.f};
        const f32x4 z4 = (f32x4){0.f, 0.f, 0.f, 0.f};
        float* ybase = Yb + (size_t)b * SEQ * 512 + 64 * h + 16 * wave; const int yoff = 4 * g * 512 + c;
        const int oA = RC_AT + c * 144 + g * 8, oR = RC_RT + c * 144 + g * 8, oBK = RC_BKT + c * 80 + g * 8, oG = RC_GT + c * 80 + g * 8;
        const int oM = (g < 2) ? RC_MT + c * 48 + g * 16 : RC_AT + 128, oV16 = RC_VT + (16 * wave + c) * 48 + (g & 1) * 16, oV8 = RC_VT + (16 * wave + c) * 48 + g * 8, oT = RC_NT + c * 64 + g * 16, oGam = RC_GAM + g * 16;
        struct Ops { bf16x8_t aA0, aA1, aR0, aR1, am, bv, ag, abk[4]; f32x4 tt, gm[4]; unsigned long long vfr; };
#define CHAIN_READ(O, in) do { \
            O.aA0 = frag2((in) + oA, 32); O.aA1 = frag2((in) + oA + 64, 32); O.aR0 = frag2((in) + oR, 32); O.aR1 = frag2((in) + oR + 64, 32);     \
            O.am = *(const LAS bf16x8_t*)((in) + oM); O.bv = *(const LAS bf16x8_t*)((in) + oV16);                                                 \
            O.tt = *(const LAS f32x4*)((in) + oT);                                                                                                \
            O.vfr = *(const LAS unsigned long long*)((in) + oV8);                                                                                 \
            _Pragma("unroll") for (int kt = 0; kt < 4; ++kt) { O.abk[kt] = frag2((in) + oBK + kt * 16 * 80, 32); O.gm[kt] = *(const LAS f32x4*)((in) + oGam + kt * 64); }     \
            O.ag = frag2((in) + oG, 32);                                                                                                          \
        } while (0)
        CHAIN_LBAR;
        Ops opA, opB; CHAIN_READ(opA, lds);
        __builtin_amdgcn_s_waitcnt(0xC07F);
#define CHAIN_STEP(cur, nxt, cc, IMGN) do { \
            CHAIN_READ(nxt, lds + (IMGN) * RC_BYTES);                  \
            __builtin_amdgcn_sched_barrier(0); \
              \
            v4u s0, s1; \
            s0.x = cvtpk(ST[0][0], ST[0][1]); s0.y = cvtpk(ST[0][2], ST[0][3]); s0.z = cvtpk(ST[1][0], ST[1][1]); s0.w = cvtpk(ST[1][2], ST[1][3]); \
            s1.x = cvtpk(ST[2][0], ST[2][1]); s1.y = cvtpk(ST[2][2], ST[2][3]); s1.z = cvtpk(ST[3][0], ST[3][1]); s1.w = cvtpk(ST[3][2], ST[3][3]); \
            const bf16x8_t bS0 = __builtin_bit_cast(bf16x8_t, s0), bS1 = __builtin_bit_cast(bf16x8_t, s1); \
              \
            const f32x4 xv = __builtin_amdgcn_mfma_f32_16x16x32_bf16(cur.am, cur.bv, z4, 0, 0, 0), xa = __builtin_amdgcn_mfma_f32_16x16x32_bf16(cur.aA0, bS0, z4, 0, 0, 0), xb = __builtin_amdgcn_mfma_f32_16x16x32_bf16(cur.aA1, bS1, z4, 0, 0, 0); \
            f32x4 xr = __builtin_amdgcn_mfma_f32_16x16x32_bf16(cur.aR0, bS0, z4, 0, 0, 0); \
            xr = __builtin_amdgcn_mfma_f32_16x16x32_bf16(cur.aR1, bS1, xr, 0, 0, 0); \
            const f32x4 x = xa + xb + xv; \
              \
            f32x4 ua = __builtin_amdgcn_mfma_f32_16x16x4f32(cur.tt[0], x[0], z4, 0, 0, 0), ub = __builtin_amdgcn_mfma_f32_16x16x4f32(cur.tt[1], x[1], z4, 0, 0, 0); \
            ua = __builtin_amdgcn_mfma_f32_16x16x4f32(cur.tt[2], x[2], ua, 0, 0, 0); ub = __builtin_amdgcn_mfma_f32_16x16x4f32(cur.tt[3], x[3], ub, 0, 0, 0); \
            const f32x4 u = ua + ub; \
            v4u uvw; uvw.x = cvtpk(u[0], u[1]); uvw.y = cvtpk(u[2], u[3]); uvw.z = (unsigned)cur.vfr; uvw.w = (unsigned)(cur.vfr >> 32);            \
            const bf16x8_t bUV = __builtin_bit_cast(bf16x8_t, uvw); \
              \
            _Pragma("unroll") for (int kt = 0; kt < 4; ++kt) ST[kt] = __builtin_amdgcn_mfma_f32_16x16x32_bf16(cur.abk[kt], bUV, ST[kt] * cur.gm[kt], 0, 0, 0); \
            const f32x4 y = __builtin_amdgcn_mfma_f32_16x16x32_bf16(cur.ag, bUV, xr, 0, 0, 0); \
            { float* yc = ybase + (size_t)(16 * (cc)) * 512; _Pragma("unroll") for (int i = 0; i < 4; ++i) yc[yoff + i * 512] = y[i]; } \
            CHAIN_LBAR; \
        } while (0)
#pragma unroll 1
        for (int cc = 0; cc < NCK; cc += 4) { CHAIN_STEP(opA, opB, cc, 1); CHAIN_STEP(opB, opA, cc + 1, 2); CHAIN_STEP(opA, opB, cc + 2, 3); CHAIN_STEP(opB, opA, cc + 3, 0); }
#undef CHAIN_STEP
#undef CHAIN_READ
    }
    __syncthreads();
}

struct RwkvP { const float *mu, *w0, *w2, *a0, *a2, *g2, *k_k, *k_a, *r_k, *v0, *v1, *v2; const v4u* lora; };
constexpr int PR_XA = 0;
constexpr int PR_VT = 21248;
constexpr int PR_UP = 58112;
constexpr int PR_U = 135168;
constexpr int PD_TA = 0, PD_TR = 2304, PD_TB = 4608, PD_TK = 6912, PD_TV = 9216, PD_TG = 11520, PD_NT = 11776  , PD_WAVE = 12800, PD_STASH = 8 * PD_WAVE;
__device__ __forceinline__ bf16x8_t pack8(const float (&x)[8]) { v4u w; w.x = cvtpk(x[0], x[1]); w.y = cvtpk(x[2], x[3]); w.z = cvtpk(x[4], x[5]); w.w = cvtpk(x[6], x[7]); return __builtin_bit_cast(bf16x8_t, w); }
__device__ __forceinline__ float fsigmoid(float x) { return 1.f / (1.f + __expf(-x)); }

__device__ __forceinline__ void shifted4(const bf16* __restrict__ colp  , int tl0, bool first, const f32x4 mu, float (&out)[4][4]) {
    float rows[5][4];
#pragma unroll
    for (int ii = 0; ii < 5; ++ii) {
        const int tl = tl0 - 1 + ii;
        if (tl < 0 && first) { rows[ii][0] = 0.f; rows[ii][1] = 0.f; rows[ii][2] = 0.f; rows[ii][3] = 0.f; }
        else unpack4(*(const unsigned long long*)(colp + (ptrdiff_t)tl * IN_W), rows[ii]);
    }
#pragma unroll
    for (int i = 0; i < 4; ++i)
#pragma unroll
        for (int e = 0; e < 4; ++e) out[i][e] = rows[i + 1][e] + (rows[i][e] - rows[i + 1][e]) * mu[e];
}

__device__ __forceinline__ void prep_tile(LAS unsigned char* lds, int tt, int tid, const bf16* __restrict__ PROJ, const float* __restrict__ cw, const RwkvP& W, int layer,
                                          float* __restrict__ scanb, float* __restrict__ sc2, float* __restrict__ vfirst, bf16* __restrict__ MIX) {
    unsigned char* recs = (unsigned char*)scanb;
    asm volatile("" : "+v"(tid));
    const int wave = __builtin_amdgcn_readfirstlane(tid >> 6), lane = tid & 63, g = lane >> 4, c = lane & 15, h = wave;
    const int tok0 = tt * 32; const bool first = (tok0 % SEQ) == 0;
    for (int rp_ = 0; rp_ < REP_P1; ++rp_) {
        const int ti = tid >> 4, t = (tok0 + ti) % SEQ;
        const bf16* row = PROJ + (size_t)(tok0 + ti) * IN_W;
        const v4u z4u = (v4u){0u, 0u, 0u, 0u};
        v4u Lb[4], Lc0[4], Lu0[4], Lc1[4], Lu1[4], Lc2[4], Lu2[4];
#pragma unroll
        for (int qq = 0; qq < 4; ++qq) { const int ch8 = ((tid & 15) + 16 * qq) * 8;
            Lb[qq] = *(const v4u*)(row + OFF_CB + ch8); Lc0[qq] = *(const v4u*)(row + OFF_CC + ch8); Lu0[qq] = *(const v4u*)(row + OFF_CU + ch8);
            Lc1[qq] = (t >= 1) ? *(const v4u*)(row - IN_W + OFF_CC + ch8) : z4u; Lu1[qq] = (t >= 1) ? *(const v4u*)(row - IN_W + OFF_CU + ch8) : z4u;
            Lc2[qq] = (t >= 2) ? *(const v4u*)(row - 2 * IN_W + OFF_CC + ch8) : z4u; Lu2[qq] = (t >= 2) ? *(const v4u*)(row - 2 * IN_W + OFF_CU + ch8) : z4u; }
#pragma unroll
        for (int qq = 0; qq < 4; ++qq) {
            const int ch8 = ((tid & 15) + 16 * qq) * 8;
            float cb[8], c0[8], u0[8], c1[8], u1[8], c2[8], u2[8];
            unpack8(Lb[qq], cb); unpack8(Lc0[qq], c0); unpack8(Lu0[qq], u0); unpack8(Lc1[qq], c1); unpack8(Lu1[qq], u1); unpack8(Lc2[qq], c2); unpack8(Lu2[qq], u2);
            float y[8];
#pragma unroll
            for (int e = 0; e < 8; ++e) y[e] = cb[e] * (cw[ch8 + e] * (c2[e] * u2[e]) + cw[512 + ch8 + e] * (c1[e] * u1[e]) + cw[1024 + ch8 + e] * (c0[e] * u0[e]));
            *(v4u*)(MIX + (size_t)(tok0 + ti) * D_MODEL + ch8) = __builtin_bit_cast(v4u, pack8(y));
        }
    }
    {
        const int ti = tid >> 4, cq = tid & 15, t = (tok0 + ti) % SEQ;
        const bf16* rp = PROJ + (size_t)(tok0 + ti) * IN_W + OFF_RW + 1536 + 16 * cq;
        float cur[16], prv[16];
        unpack8(*(const v4u*)rp, *(float(*)[8])&cur[0]); unpack8(*(const v4u*)(rp + 8), *(float(*)[8])&cur[8]);
        if (t > 0) { unpack8(*(const v4u*)(rp - IN_W), *(float(*)[8])&prv[0]); unpack8(*(const v4u*)(rp - IN_W + 8), *(float(*)[8])&prv[8]); }
        else {
#pragma unroll
            for (int e = 0; e < 16; ++e) prv[e] = 0.f; }
        float x[16];
#pragma unroll
        for (int e = 0; e < 16; ++e) x[e] = cur[e] + (prv[e] - cur[e]) * W.mu[1536 + 16 * cq + e];
        if (cq < 4) {
#pragma unroll
            for (int e = 0; e < 16; ++e) x[e] = 1.f - 2.f / (1.f + __expf(2.f * x[e]));
        } else if (cq >= 8) {
#pragma unroll
            for (int e = 0; e < 16; ++e) x[e] = fsigmoid(x[e]); }
        LAS unsigned char* xa = lds + PR_XA + ti * 528 + 16 * cq * 2;
        *(LAS bf16x8_t*)xa = pack8(*(float(*)[8])&x[0]); *(LAS bf16x8_t*)(xa + 16) = pack8(*(float(*)[8])&x[8]);
    }
    __syncthreads();
    const int ch = 64 * h + 4 * c;
    const size_t SB = (size_t)M_TOK * 512;
    f32x4 decr[2][4];
    for (int rp_ = 0; rp_ < REP_P2; ++rp_) {
        f32x4 az[2][4];
#pragma unroll
        for (int mt = 0; mt < 2; ++mt)
#pragma unroll
            for (int nt = 0; nt < 4; ++nt) az[mt][nt] = (f32x4){0.f, 0.f, 0.f, 0.f};
#pragma unroll
        for (int ks = 0; ks < 2; ++ks) {
            f32x4 bw[8];
#pragma unroll
            for (int jx = 0; jx < 8; ++jx) bw[jx] = *(const f32x4*)(W.w2 + (size_t)(32 * ks + 8 * g + jx) * 512 + 64 * h + 4 * c);
            const bf16x8_t af0 = *(const LAS bf16x8_t*)(lds + PR_XA + c * 528 + (32 * ks + 8 * g) * 2), af1 = *(const LAS bf16x8_t*)(lds + PR_XA + (16 + c) * 528 + (32 * ks + 8 * g) * 2);
#pragma unroll
            for (int nt = 0; nt < 4; ++nt) {
                const float col[8] = {bw[0][nt], bw[1][nt], bw[2][nt], bw[3][nt], bw[4][nt], bw[5][nt], bw[6][nt], bw[7][nt]};
                const bf16x8_t bf = pack8(col);
                az[0][nt] = __builtin_amdgcn_mfma_f32_16x16x32_bf16(af0, bf, az[0][nt], 0, 0, 0); az[1][nt] = __builtin_amdgcn_mfma_f32_16x16x32_bf16(af1, bf, az[1][nt], 0, 0, 0);
            }
        }
        const f32x4 w0v = *(const f32x4*)(W.w0 + ch);
#pragma unroll
        for (int mt = 0; mt < 2; ++mt)
#pragma unroll
            for (int i = 0; i < 4; ++i) {
#pragma unroll
                for (int e = 0; e < 4; ++e) decr[mt][i][e] = __expf(-0.60653065971f * fsigmoid(az[mt][e][i] + w0v[e])); }
    }
    f32x4 av[2][4];
    for (int rp_ = 0; rp_ < REP_P3; ++rp_) {
        f32x4 aa[2][4], ag[2][4];
#pragma unroll
        for (int mt = 0; mt < 2; ++mt)
#pragma unroll
            for (int nt = 0; nt < 4; ++nt) { aa[mt][nt] = (f32x4){0.f, 0.f, 0.f, 0.f}; ag[mt][nt] = (f32x4){0.f, 0.f, 0.f, 0.f}; }
#pragma unroll
        for (int half = 0; half < 2; ++half) {
            v4u fr[3][4];
#pragma unroll
            for (int k3 = 0; k3 < 3; ++k3)
#pragma unroll
                for (int nt = 0; nt < 4; ++nt) fr[k3][nt] = W.lora[(((3 * half + k3) * 8 + h) * 4 + nt) * 64 + lane];
#pragma unroll
            for (int k3 = 0; k3 < 3; ++k3) {
                const int ks = 3 * half + k3;
                const bf16x8_t af0 = *(const LAS bf16x8_t*)(lds + PR_XA + c * 528 + (64 + 32 * ks + 8 * g) * 2), af1 = *(const LAS bf16x8_t*)(lds + PR_XA + (16 + c) * 528 + (64 + 32 * ks + 8 * g) * 2);
#pragma unroll
                for (int nt = 0; nt < 4; ++nt) {
                    const bf16x8_t bf = __builtin_bit_cast(bf16x8_t, fr[k3][nt]);
                    if (ks < 2) { aa[0][nt] = __builtin_amdgcn_mfma_f32_16x16x32_bf16(af0, bf, aa[0][nt], 0, 0, 0); aa[1][nt] = __builtin_amdgcn_mfma_f32_16x16x32_bf16(af1, bf, aa[1][nt], 0, 0, 0); }
                    else { ag[0][nt] = __builtin_amdgcn_mfma_f32_16x16x32_bf16(af0, bf, ag[0][nt], 0, 0, 0); ag[1][nt] = __builtin_amdgcn_mfma_f32_16x16x32_bf16(af1, bf, ag[1][nt], 0, 0, 0); }
                }
            }
        }
        const f32x4 a0v = *(const f32x4*)(W.a0 + ch);
#pragma unroll
        for (int mt = 0; mt < 2; ++mt)
#pragma unroll
            for (int i = 0; i < 4; ++i) { f32x4 gv;
#pragma unroll
                for (int e = 0; e < 4; ++e) { gv[e] = ag[mt][e][i]; av[mt][i][e] = fsigmoid(aa[mt][e][i] + a0v[e]); }
                *(unsigned long long*)((bf16*)(scanb + 6 * SB) + (size_t)(tok0 + 16 * mt + 4 * g + i) * 512 + ch) = (unsigned long long)cvtpk(gv[0], gv[1]) | ((unsigned long long)cvtpk(gv[2], gv[3]) << 32); }
    }
    asm volatile("" ::: "memory");
    const bf16* rwp = PROJ + (size_t)tok0 * IN_W + OFF_RW + 64 * h + 4 * c;
    const f32x4 mu_r = *(const f32x4*)(W.mu + 64 * h + 4 * c), mu_k = *(const f32x4*)(W.mu + 512 + 64 * h + 4 * c), mu_v = *(const f32x4*)(W.mu + 1024 + 64 * h + 4 * c);
    f32x4 agt[2][4];
    if (layer > 0) {
        LAS unsigned char* vt = lds + PR_VT + wave * 4608;
#pragma unroll
        for (int mt = 0; mt < 2; ++mt) {
            float vv[4][4];
            shifted4(rwp + 1024, 16 * mt + 4 * g, first, mu_v, vv);
#pragma unroll
            for (int i = 0; i < 4; ++i) *(LAS unsigned long long*)(vt + ((16 * mt + 4 * g + i) * 72 + 4 * c) * 2) = (unsigned long long)cvtpk(vv[i][0], vv[i][1]) | ((unsigned long long)cvtpk(vv[i][2], vv[i][3]) << 32);
        }
        f32x4 au[2][2];
#pragma unroll
        for (int mt = 0; mt < 2; ++mt)
#pragma unroll
            for (int n2 = 0; n2 < 2; ++n2) au[mt][n2] = (f32x4){0.f, 0.f, 0.f, 0.f};
#pragma unroll
        for (int ks = 0; ks < 2; ++ks) {
            const bf16x8_t af0 = *(const LAS bf16x8_t*)(vt + (c * 72 + 32 * ks + 8 * g) * 2), af1 = *(const LAS bf16x8_t*)(vt + ((16 + c) * 72 + 32 * ks + 8 * g) * 2);
#pragma unroll
            for (int n2 = 0; n2 < 2; ++n2) {
                float col[8];
#pragma unroll
                for (int jx = 0; jx < 8; ++jx) col[jx] = W.v1[(size_t)(64 * h + 32 * ks + 8 * g + jx) * 32 + 16 * n2 + c];
                const bf16x8_t bf = pack8(col);
                au[0][n2] = __builtin_amdgcn_mfma_f32_16x16x32_bf16(af0, bf, au[0][n2], 0, 0, 0); au[1][n2] = __builtin_amdgcn_mfma_f32_16x16x32_bf16(af1, bf, au[1][n2], 0, 0, 0);
            }
        }
        LAS float* up = (LAS float*)(lds + PR_UP) + wave * 1056;
#pragma unroll
        for (int mt = 0; mt < 2; ++mt)
#pragma unroll
            for (int n2 = 0; n2 < 2; ++n2)
#pragma unroll
                for (int i = 0; i < 4; ++i) up[(16 * mt + 4 * g + i) * 33 + 16 * n2 + c] = au[mt][n2][i];
        __syncthreads();
#pragma unroll
        for (int o2 = 0; o2 < 2; ++o2) { const int o = tid + 512 * o2, tk = o >> 5, n = o & 31; float sacc = 0.f;
#pragma unroll
            for (int w8 = 0; w8 < 8; ++w8) sacc += ((const LAS float*)(lds + PR_UP))[w8 * 1056 + tk * 33 + n];
            ((LAS float*)(lds + PR_U))[tk * 36 + n] = sacc; }
        __syncthreads();
        f32x4 bw[8];
#pragma unroll
        for (int jx = 0; jx < 8; ++jx) bw[jx] = *(const f32x4*)(W.v2 + (size_t)(8 * g + jx) * 512 + 64 * h + 4 * c);
        bf16x8_t afm[2];
#pragma unroll
        for (int mt = 0; mt < 2; ++mt) { const LAS float* ur = (const LAS float*)(lds + PR_U) + (16 * mt + c) * 36 + 8 * g; float uu[8];
#pragma unroll
            for (int jx = 0; jx < 8; ++jx) uu[jx] = ur[jx];
            afm[mt] = pack8(uu); }
#pragma unroll
        for (int nt = 0; nt < 4; ++nt) {
            const float col[8] = {bw[0][nt], bw[1][nt], bw[2][nt], bw[3][nt], bw[4][nt], bw[5][nt], bw[6][nt], bw[7][nt]};
            const bf16x8_t bf = pack8(col);
            agt[0][nt] = __builtin_amdgcn_mfma_f32_16x16x32_bf16(afm[0], bf, (f32x4){0.f, 0.f, 0.f, 0.f}, 0, 0, 0);
            agt[1][nt] = __builtin_amdgcn_mfma_f32_16x16x32_bf16(afm[1], bf, (f32x4){0.f, 0.f, 0.f, 0.f}, 0, 0, 0);
        }
    }
    __syncthreads();
    LAS unsigned long long* stash_av = (LAS unsigned long long*)(lds + PD_STASH + wave * 4096);
    LAS unsigned long long* stash_gt = (LAS unsigned long long*)(lds + PD_STASH + wave * 4096 + 2048);
#pragma unroll
    for (int i = 0; i < 4; ++i) stash_av[i * 64 + lane] = (unsigned long long)cvtpk(av[1][i][0], av[1][i][1]) | ((unsigned long long)cvtpk(av[1][i][2], av[1][i][3]) << 32);
    if (layer > 0) {
#pragma unroll
        for (int e = 0; e < 4; ++e) stash_gt[e * 64 + lane] = (unsigned long long)cvtpk(agt[1][e][0], agt[1][e][1]) | ((unsigned long long)cvtpk(agt[1][e][2], agt[1][e][3]) << 32); }
    const f32x4 kkv = *(const f32x4*)(W.k_k + ch), kav = *(const f32x4*)(W.k_a + ch), rkv = *(const f32x4*)(W.r_k + ch);
    f32x4 v0v = (f32x4){0.f, 0.f, 0.f, 0.f}; if (layer > 0) v0v = *(const f32x4*)(W.v0 + ch);
    LAS unsigned char* pt = lds + wave * PD_WAVE;
    for (int rp_ = 0; rp_ < REP_P4; ++rp_)
#pragma unroll
    for (int mt = 0; mt < 2; ++mt) {
        asm volatile("" ::: "memory");
        unsigned char* rec = recs + ((size_t)((tok0 + 16 * mt) >> 4) * 8 + h) * RG_BYTES;
        f32x4 avm[4], agm[4];
        if (mt == 0) {
#pragma unroll
            for (int i = 0; i < 4; ++i) { avm[i] = av[0][i]; agm[i] = agt[0][i]; }
        } else {
#pragma unroll
            for (int i = 0; i < 4; ++i) { float t4[4]; unpack4(stash_av[i * 64 + lane], t4); avm[i] = (f32x4){t4[0], t4[1], t4[2], t4[3]};
                if (layer > 0) { unpack4(stash_gt[i * 64 + lane], t4); agm[i] = (f32x4){t4[0], t4[1], t4[2], t4[3]}; } else agm[i] = (f32x4){0.f, 0.f, 0.f, 0.f}; }
        }
        float rr[4][4], kx[4][4], vv[4][4];
        f32x4 gm[4], Eg, Gtot;
        {
#pragma unroll
            for (int i = 0; i < 4; ++i) { const f32x4 d = decr[mt][i];
                gm[i] = (i == 0) ? d : gm[i > 0 ? i - 1 : 0] * d; }
            f32x4 t0, t1, t2, t3;
#pragma unroll
            for (int e = 0; e < 4; ++e) { t0[e] = __shfl(gm[3][e], c); t1[e] = __shfl(gm[3][e], c + 16); t2[e] = __shfl(gm[3][e], c + 32); t3[e] = __shfl(gm[3][e], c + 48); }
            Eg = (g == 0) ? (f32x4){1.f, 1.f, 1.f, 1.f} : (g == 1) ? t0 : (g == 2) ? t0 * t1 : t0 * t1 * t2;
            Gtot = (t0 * t1) * (t2 * t3);
            if (g == 0) { *(f32x4*)(rec + RG_GAM + 16 * c) = Gtot; *(LAS f32x4*)(pt + PD_TG + 16 * c) = Gtot; }
#pragma unroll
            for (int i = 0; i < 4; ++i) gm[i] = gm[i] * Eg;
        }
        asm volatile("" ::: "memory");
        shifted4(rwp, 16 * mt + 4 * g, first, mu_r, rr); shifted4(rwp + 512, 16 * mt + 4 * g, first, mu_k, kx); shifted4(rwp + 1024, 16 * mt + 4 * g, first, mu_v, vv);
#pragma unroll
        for (int i = 0; i < 4; ++i) {
            const size_t o = (size_t)(tok0 + 16 * mt + 4 * g + i) * 512 + ch;
            f32x4 vo, kkq, kmq, ro;
            float ssq = 0.f, bsum = 0.f;
#pragma unroll
            for (int e = 0; e < 4; ++e) {
                ro[e] = rr[i][e];
                kkq[e] = kx[i][e] * kkv[e]; ssq += kkq[e] * kkq[e];
                kmq[e] = kx[i][e] * (1.f + (avm[i][e] - 1.f) * kav[e]);
                bsum += rr[i][e] * kmq[e] * rkv[e];
            }
            if (layer > 0) { float vf[4]; unpack4(*(const unsigned long long*)((const bf16*)vfirst + o), vf);
#pragma unroll
                for (int e = 0; e < 4; ++e) vo[e] = vv[i][e] + (vf[e] - vv[i][e]) * fsigmoid(v0v[e] + agm[e][i]); }
            else { vo = (f32x4){vv[i][0], vv[i][1], vv[i][2], vv[i][3]}; *(unsigned long long*)((bf16*)vfirst + o) = (unsigned long long)cvtpk(vo[0], vo[1]) | ((unsigned long long)cvtpk(vo[2], vo[3]) << 32); }
            ssq = allreduce16(ssq); bsum = allreduce16(bsum);
            const float rn = rsqrtf(fmaxf(ssq, 1e-24f));
            f32x4 an, bn;
#pragma unroll
            for (int e = 0; e < 4; ++e) { const float kn = kkq[e] * rn; an[e] = -kn; bn[e] = kn * avm[i][e]; }
            if (c == 0) *(f32x4*)(sc2 + ((size_t)(tok0 + 16 * mt + 4 * g + i) * 8 + h) * 4) = (f32x4){0.f, 0.f, bsum, 0.f};
            const f32x4 gam = gm[i], gamp = (i == 0) ? Eg : gm[i > 0 ? i - 1 : 0];
            const f32x4 ginv = (f32x4){__builtin_amdgcn_rcpf(gam[0]), __builtin_amdgcn_rcpf(gam[1]), __builtin_amdgcn_rcpf(gam[2]), __builtin_amdgcn_rcpf(gam[3])};
            const f32x4 rt = ro * gam, at = an * gamp, bt = bn * ginv, kt = kmq * ginv;
#define PK4(val) ((unsigned long long)cvtpk((val)[0], (val)[1]) | ((unsigned long long)cvtpk((val)[2], (val)[3]) << 32))
            const unsigned long long pa = PK4(at), pr = PK4(rt), pb = PK4(bt), pk = PK4(kt), pv = PK4(vo);
#undef PK4
            const int trow = (4 * g + i) * 144 + 8 * c;
            const int grow = (4 * g + i) * 128 + 8 * c;
            *(unsigned long long*)(rec + RG_AT + grow) = pa; *(unsigned long long*)(rec + RG_RT + grow) = pr;
            *(LAS unsigned long long*)(pt + PD_TA + trow) = pa; *(LAS unsigned long long*)(pt + PD_TR + trow) = pr; *(LAS unsigned long long*)(pt + PD_TB + trow) = pb;
            *(LAS unsigned long long*)(pt + PD_TK + trow) = pk; *(LAS unsigned long long*)(pt + PD_TV + trow) = pv;
            *(unsigned long long*)((bf16*)(scanb + 5 * SB) + o) = pv;
        }
        {
            f32x4 nN = (f32x4){0.f, 0.f, 0.f, 0.f}, nM = nN, nG1 = nN, nG2 = nN;
#pragma unroll
            for (int ks = 0; ks < 2; ++ks) { const int fo = c * 144 + ks * 64 + g * 16;
                const bf16x8_t fB = *(const LAS bf16x8_t*)(pt + PD_TB + fo), fK = *(const LAS bf16x8_t*)(pt + PD_TK + fo), fA = *(const LAS bf16x8_t*)(pt + PD_TA + fo), fR = *(const LAS bf16x8_t*)(pt + PD_TR + fo);
                nN = __builtin_amdgcn_mfma_f32_16x16x32_bf16(fB, fA, nN, 0, 0, 0); nM = __builtin_amdgcn_mfma_f32_16x16x32_bf16(fK, fA, nM, 0, 0, 0);
                nG1 = __builtin_amdgcn_mfma_f32_16x16x32_bf16(fB, fR, nG1, 0, 0, 0); nG2 = __builtin_amdgcn_mfma_f32_16x16x32_bf16(fK, fR, nG2, 0, 0, 0); }
#pragma unroll
            for (int i = 0; i < 4; ++i) { const int j = 4 * g + i; if (j >= c) { nN[i] = 0.f; nM[i] = 0.f; } if (j > c) { nG1[i] = 0.f; nG2[i] = 0.f; } }
            LAS float* nt = (LAS float*)(pt + PD_NT);
            *(LAS f32x4*)(nt + c * 16 + 4 * g) = nN;
            {
                float tr[16];
#pragma unroll
                for (int t = 0; t < 16; ++t) tr[t] = (t == c) ? 1.f : 0.f;
#pragma unroll
                for (int t = 1; t < 16; ++t) {
#pragma unroll
                    for (int jb = 0; jb * 4 < t; ++jb) { const f32x4 n4 = *(const LAS f32x4*)(nt + t * 16 + jb * 4);
                        tr[t] = fmaf(tr[4 * jb], n4[0], tr[t]); if (4 * jb + 1 < t) tr[t] = fmaf(tr[4 * jb + 1], n4[1], tr[t]); if (4 * jb + 2 < t) tr[t] = fmaf(tr[4 * jb + 2], n4[2], tr[t]); if (4 * jb + 3 < t) tr[t] = fmaf(tr[4 * jb + 3], n4[3], tr[t]); }
                }
                if (g == 0) {
#pragma unroll
                    for (int t = 0; t < 16; ++t) *(float*)(rec + RG_NT + t * 64 + c * 4) = tr[t];
                }
            }
            *(unsigned long long*)(rec + RG_MT + c * 32 + g * 8) = (unsigned long long)cvtpk(nM[0], nM[1]) | ((unsigned long long)cvtpk(nM[2], nM[3]) << 32);
            *(unsigned long long*)(rec + RG_GT + c * 64 + g * 8) = (unsigned long long)cvtpk(nG1[0], nG1[1]) | ((unsigned long long)cvtpk(nG1[2], nG1[3]) << 32);
            *(unsigned long long*)(rec + RG_GT + c * 64 + 32 + g * 8) = (unsigned long long)cvtpk(nG2[0], nG2[1]) | ((unsigned long long)cvtpk(nG2[2], nG2[3]) << 32);
        }
        {
            const int tro = (4 * g + (c >> 2)) * 144 + (c & 3) * 8;
#pragma unroll
            for (int m = 0; m < 4; ++m) {
                const float gch = *(const LAS float*)(pt + PD_TG + (16 * m + c) * 4);
                const unsigned long long tb = __builtin_bit_cast(unsigned long long, __builtin_amdgcn_ds_read_tr16_b64_v4i16((LAS s16x4_t*)(pt + PD_TB + tro + m * 32)));
                const unsigned long long tk = __builtin_bit_cast(unsigned long long, __builtin_amdgcn_ds_read_tr16_b64_v4i16((LAS s16x4_t*)(pt + PD_TK + tro + m * 32)));
                const unsigned long long tv = __builtin_bit_cast(unsigned long long, __builtin_amdgcn_ds_read_tr16_b64_v4i16((LAS s16x4_t*)(pt + PD_TV + tro + m * 32)));
                float fb[4], fk[4]; unpack4(tb, fb); unpack4(tk, fk);
                unsigned char* brow = rec + RG_BKT + (16 * m + c) * 64 + g * 8;
                *(unsigned long long*)brow = (unsigned long long)cvtpk(fb[0] * gch, fb[1] * gch) | ((unsigned long long)cvtpk(fb[2] * gch, fb[3] * gch) << 32);
                *(unsigned long long*)(brow + 32) = (unsigned long long)cvtpk(fk[0] * gch, fk[1] * gch) | ((unsigned long long)cvtpk(fk[2] * gch, fk[3] * gch) << 32);
                *(unsigned long long*)(rec + RG_VT + (16 * m + c) * 32 + g * 8) = tv;
            }
        }
    }
    __syncthreads();
}

typedef GAS unsigned gu32;
#define RLX_AGENT __ATOMIC_RELAXED, __HIP_MEMORY_SCOPE_AGENT
#define XB_TMO      128
#define XB_XCNT(j)  (256  + 64 * (j))
#define XB_XSUB(j)  (1280 + 64 * (j))
#define XB_XGEN(j)  (2304 + 64 * (j))
#define XB_TOP      3328
#define XB_TOPGEN   3392
#define XCD_BAR_WORDS 3456
#define XB_SPIN_CAP (1u << 18)

__device__ __forceinline__ unsigned xb_ld(unsigned* p)              { return __hip_atomic_load(p, __ATOMIC_RELAXED, __HIP_MEMORY_SCOPE_AGENT); }
__device__ __forceinline__ unsigned xb_add(unsigned* p, unsigned v) { return __hip_atomic_fetch_add(p, v, __ATOMIC_RELAXED, __HIP_MEMORY_SCOPE_AGENT); }
__device__ __forceinline__ unsigned xb_xcc_id() { return (unsigned)__builtin_amdgcn_s_getreg((3 << 11) | 20) & 0xFu; }
#define XB_SPIN(cond, bar) do { unsigned _sp = 0; while (cond) { __builtin_amdgcn_s_sleep(1); \
    if ((++_sp & 255u) == 0u) { if (xb_ld(&(bar)[XB_TMO])) break; if (_sp > XB_SPIN_CAP) { atomicAdd(&(bar)[XB_TMO], 1u); break; } } } } while (0)

struct XcdBarrier {
    unsigned* bar; unsigned x;
    volatile LAS unsigned* st;
};

__device__ __forceinline__ XcdBarrier xcd_barrier_post(unsigned* bar, volatile LAS unsigned* st) {
    XcdBarrier b; b.bar = bar; b.x = xb_xcc_id(); b.st = st;
    if (threadIdx.x == 0) (void)xb_add(&bar[XB_XCNT(b.x)], 1u);
    return b;
}
__device__ __forceinline__ void xcd_barrier_complete(unsigned* bar, unsigned x, unsigned& nloc, unsigned& nx) {
    const unsigned G = gridDim.x * gridDim.y * gridDim.z;
    unsigned sum, cnt, mine, sp = 0u;
    for (;;) {
        sum = 0u; cnt = 0u; mine = 0u;
#pragma unroll
        for (unsigned j = 0; j < 16; ++j) { const unsigned c = xb_ld(&bar[XB_XCNT(j)]); sum += c; cnt += (c > 0u) ? 1u : 0u; mine = (j == x) ? c : mine; }
        if (sum == G) break;
        __builtin_amdgcn_s_sleep(1);
        if ((++sp & 255u) == 0u) { if (xb_ld(&bar[XB_TMO])) break; if (sp > XB_SPIN_CAP) { atomicAdd(&bar[XB_TMO], 1u); break; } }
    }
    nloc = mine > 0u ? mine : 1u; nx = cnt > 0u ? cnt : 1u;
}

__device__ __forceinline__ void xcd_barrier(const XcdBarrier& b) {
    asm volatile("s_waitcnt vmcnt(0)" ::: "memory");
    __syncthreads();
    if (threadIdx.x == 0) {
        unsigned* bar = b.bar;
        __builtin_amdgcn_s_waitcnt(0);
        unsigned nloc = b.st[0], nx = b.st[1];
        if (nloc == 0u) { xcd_barrier_complete(bar, b.x, nloc, nx); b.st[0] = nloc; b.st[1] = nx; }
        const unsigned old = xb_add(&bar[XB_XSUB(b.x)], 1u);
        const unsigned gen = old / nloc;
        if (old + 1u == (gen + 1u) * nloc) {
            __builtin_amdgcn_fence(__ATOMIC_RELEASE, "agent");
            asm volatile("s_waitcnt vmcnt(0)" ::: "memory");
            const unsigned og = xb_add(&bar[XB_TOP], 1u);
            const unsigned tg = og / nx;
            if (og + 1u == (tg + 1u) * nx) xb_add(&bar[XB_TOPGEN], 1u);
            else XB_SPIN(xb_ld(&bar[XB_TOPGEN]) == tg, bar);
            __builtin_amdgcn_fence(__ATOMIC_ACQUIRE, "agent");
            xb_add(&bar[XB_XGEN(b.x)], 1u);
            asm volatile("s_waitcnt vmcnt(0)" ::: "memory");
        } else {
            XB_SPIN(xb_ld(&bar[XB_XGEN(b.x)]) == gen, bar);
            __builtin_amdgcn_fence(__ATOMIC_ACQUIRE, "agent");
            asm volatile("s_waitcnt vmcnt(0)" ::: "memory");
        }
    }
    __syncthreads();
}


constexpr int NWAVES = 8;
constexpr size_t MiB = 1u << 20;
constexpr size_t WS_CTL = 0;
constexpr size_t WS_WT = 2 * MiB;
constexpr size_t WT_LAYER = 94 * MiB, WT_IN = 0, WT_OUT = 22 * MiB, WT_UP = 30 * MiB, WT_DOWN = 62 * MiB;
constexpr size_t WS_HN = 192 * MiB;
constexpr size_t WS_VFIRST = 224 * MiB;
constexpr size_t WS_PROJ = 240 * MiB;
constexpr size_t WS_MIX = 328 * MiB;
constexpr size_t WS_SCAN = 360 * MiB;
constexpr size_t WS_H = 240 * MiB;
constexpr size_t OUT_DILO = 0, OUT_DILL = 24 * MiB, OUT_SC2 = 25 * MiB;
constexpr size_t WS_SSPF = 190 * MiB;
constexpr size_t WS_LORA = 191 * MiB;
constexpr size_t WS_SSP = 1 * MiB;
constexpr size_t WS_END = 504 * MiB;
constexpr int N_SCAN_WG = BATCH * 8;
constexpr int LDS_BYTES = 147456;

struct Params { const float* in[28]; float* out; unsigned char* ws; int ph_lo, ph_hi; };

__device__ __forceinline__ void transpose_item(const float* W, int K, int N, bf16* WT, LAS float* scr, int item, int lane) {
    const int nblk = N / 32, kb = item / nblk, nb = item % nblk, k0 = 64 * kb, n0 = 32 * nb;
    const int kr = lane >> 3, nq = lane & 7;
    f32x4 v[8];
#pragma unroll
    for (int i = 0; i < 8; ++i) v[i] = __builtin_nontemporal_load((const f32x4*)(W + (size_t)(k0 + 8 * i + kr) * N + n0 + 4 * nq));
#pragma unroll
    for (int i = 0; i < 8; ++i) { LAS float* d = scr + (8 * i + kr) * 33 + 4 * nq; d[0] = v[i].x; d[1] = v[i].y; d[2] = v[i].z; d[3] = v[i].w; }
    asm volatile("s_waitcnt lgkmcnt(0)" ::: "memory");
    const int c = lane & 7;
#pragma unroll
    for (int j = 0; j < 4; ++j) { const int n = (lane >> 3) + 8 * j; const LAS float* s = scr + (8 * c) * 33 + n;
        v4u o; o.x = pk2(s[0 * 33], s[1 * 33]); o.y = pk2(s[2 * 33], s[3 * 33]); o.z = pk2(s[4 * 33], s[5 * 33]); o.w = pk2(s[6 * 33], s[7 * 33]);
        *(v4u*)(WT + (size_t)(n0 + n) * K + k0 + 8 * c) = o; }
    asm volatile("s_waitcnt lgkmcnt(0)" ::: "memory");
}
__device__ __forceinline__ void row_to_bf16_ssq(const float* xrow, const float* g, bf16* orow, float* ssprow, int lane) {
    const f32x4* xr = (const f32x4*)xrow + lane; const f32x4* gr = (const f32x4*)g + lane;
    f32x4 v[8]; float s = 0.f;
#pragma unroll
    for (int j = 0; j < 8; ++j) { v[j] = xr[64 * j]; s += (v[j].x * v[j].x + v[j].y * v[j].y) + (v[j].z * v[j].z + v[j].w * v[j].w); }
    s = wave_sum(s);
    if (lane < 32) ssprow[lane] = (lane == 0) ? s : 0.f;
    unsigned long long* o8 = (unsigned long long*)orow + lane;
#pragma unroll
    for (int j = 0; j < 8; ++j) { const f32x4 gg = gr[64 * j]; o8[64 * j] = (unsigned long long)pk2(v[j].x * gg.x, v[j].y * gg.y) | ((unsigned long long)pk2(v[j].z * gg.z, v[j].w * gg.w) << 32); }
}

__device__ __forceinline__ void conv_job(const Params& p, unsigned char* ws, int l, int i0, int i1, int wv, int nw, LAS float* scr, int lane) {
    unsigned char* wtl = ws + WS_WT + l * WT_LAYER;
    constexpr int I_OUT = (D_MODEL / 64) * (D_MODEL / 32), I_UP = (D_MODEL / 64) * (D_FF / 32), I_DOWN = (D_FF / 64) * (D_MODEL / 32);
    for (int it = i0 + wv; it < i1; it += nw) {
        int r = it;
        if (r >= I_OUT + I_UP + I_DOWN) { transpose_item(p.in[2] + (size_t)(l + 1) * D_MODEL * IN_W, D_MODEL, IN_W, (bf16*)(ws + WS_WT + (l + 1) * WT_LAYER + WT_IN), scr, r - (I_OUT + I_UP + I_DOWN), lane); continue; }
        if (r < I_OUT) { transpose_item(p.in[23] + (size_t)l * D_MODEL * D_MODEL, D_MODEL, D_MODEL, (bf16*)(wtl + WT_OUT), scr, r, lane); continue; } r -= I_OUT;
        if (r < I_UP) { transpose_item(p.in[25] + (size_t)l * D_MODEL * D_FF, D_MODEL, D_FF, (bf16*)(wtl + WT_UP), scr, r, lane); continue; } r -= I_UP;
        transpose_item(p.in[26] + (size_t)l * D_FF * D_MODEL, D_FF, D_MODEL, (bf16*)(wtl + WT_DOWN), scr, r, lane);
    }
}
constexpr int CJ_TOTAL = (D_MODEL / 64) * (D_MODEL / 32) + (D_MODEL / 64) * (D_FF / 32) + (D_FF / 64) * (D_MODEL / 32);
#ifndef CJ_EARLY
#define CJ_EARLY 6144
#endif
constexpr int GIN_FULL = (M_TOK / 256) * (IN_W / 256) - 2 * 256;

#ifndef DUP_SUB
#define DUP_SUB (-1)
#endif
#ifndef REP_SCAN
#define REP_SCAN 1
#endif
#ifndef REP_ATT
#define REP_ATT 1
#define STAGGER_UP 6
#endif
#ifndef DUP0
#define DUP0 0
#endif
constexpr int PH_PER_LAYER = 7, SLOTS = PH_PER_LAYER + (DUP_SUB >= 0 ? 1 : 0), N_PHASES = 1 + DUP0 + SLOTS * DEPTH;

__global__ void __launch_bounds__(NWAVES * 64, 2) mk_fwd(Params p) {
    extern __shared__ __attribute__((aligned(16))) unsigned char lds_raw[];
    LAS unsigned char* lds = (LAS unsigned char*)lds_raw;
    const int wave = __builtin_amdgcn_readfirstlane((int)threadIdx.x >> 6);
    const int G = gridDim.x, bx = blockIdx.x;
    const int gw = bx * NWAVES + wave, NGW = G * NWAVES;
    unsigned char* ws = p.ws;
    bf16* HN = (bf16*)(ws + WS_HN); bf16* PROJ = (bf16*)(ws + WS_PROJ); bf16* MIX = (bf16*)(ws + WS_MIX); bf16* HB = (bf16*)(ws + WS_H); float* SSP = (float*)(ws + WS_SSP); float* SSPF = (float*)(ws + WS_SSPF);
    volatile LAS unsigned* bst = (volatile LAS unsigned*)(lds + LDS_BYTES - 64);
    if (threadIdx.x < 16) bst[threadIdx.x] = 0u;
    __syncthreads();
    XcdBarrier xbar = xcd_barrier_post((unsigned*)(ws + WS_CTL), bst);
    for (int ph = p.ph_lo; ph < p.ph_hi; ++ph) {
        if (ph > p.ph_lo) xcd_barrier(xbar);
        int tid = threadIdx.x; asm volatile("" : "+v"(tid));
        const int lane = tid & 63;
        if (ph <= DUP0) {
            LAS float* scr = (LAS float*)(lds + wave * 16384);
            constexpr int I_IN = (D_MODEL / 64) * (IN_W / 32);
            for (int it = gw; it < I_IN; it += NGW) transpose_item(p.in[2], D_MODEL, IN_W, (bf16*)(ws + WS_WT + WT_IN), scr, it, lane);
            {
                v4u* FR = (v4u*)(ws + WS_LORA);
                for (int idx = (int)blockIdx.x * (NWAVES * 64) + tid; idx < DEPTH * 6 * 8 * 4 * 64; idx += (int)gridDim.x * (NWAVES * 64)) {
                    const int ln = idx & 63, nt = (idx >> 6) & 3, hh = (idx >> 8) & 7, ks = (idx >> 11) % 6, ll = (idx >> 11) / 6, gg = ln >> 4, cc = ln & 15;
                    const float* Wt = (ks < 2) ? p.in[13] + (size_t)ll * 64 * 512 + (size_t)(32 * ks + 8 * gg) * 512 : p.in[14] + (size_t)ll * 128 * 512 + (size_t)(32 * (ks - 2) + 8 * gg) * 512;
                    float col[8];
#pragma unroll
                    for (int jx = 0; jx < 8; ++jx) col[jx] = Wt[(size_t)jx * 512 + 64 * hh + 4 * cc + nt];
                    FR[idx] = __builtin_bit_cast(v4u, pack8(col));
                }
            }
            for (int m = gw; m < M_TOK; m += NGW) row_to_bf16_ssq(p.in[0] + (size_t)m * D_MODEL, p.in[1], HN + (size_t)m * D_MODEL, SSP + (size_t)m * 32, lane);
            continue;
        }
        const int l = (ph - 1 - DUP0) / SLOTS, slot = (ph - 1 - DUP0) % SLOTS, sub = (DUP_SUB >= 0 && slot > DUP_SUB) ? slot - 1 : slot;
        const unsigned char* wt = ws + WS_WT + l * WT_LAYER;
        if (sub == 0) {
            for (int st_ = 0; st_ < ((bx >> 3) & 3) * STAGGER_UP; ++st_) __builtin_amdgcn_s_sleep(8);
            pg8::Gemm g{HN, (const bf16*)(wt + WT_IN), M_TOK, IN_W, D_MODEL}; pg8::StaticOrder S; S.init(M_TOK, IN_W, G, bx);
            pg8::EpiBf16<0> E{PROJ, IN_W, SSP};
            pg8::gemm_phase<pg8::EpiBf16<0>, pg8::StaticOrder, true, true>(lds, g, S, E);
            if (G == 256 && bx >= GIN_FULL) conv_job(p, ws, l, 0, CJ_EARLY, (bx - GIN_FULL) * NWAVES + wave, (G - GIN_FULL) * NWAVES, (LAS float*)(lds + wave * 16384), lane);
        } else if (sub == 4) {
            pg8::Gemm g{MIX, (const bf16*)(wt + WT_OUT), M_TOK, D_MODEL, D_MODEL}; pg8::StaticOrder S; S.init(M_TOK, D_MODEL, G, bx);
            if (l == 0) { pg8::EpiRes<0, false, true, false> E{nullptr, p.in[0], D_MODEL, HN, p.in[24], SSPF, nullptr, nullptr};
                pg8::gemm_phase<pg8::EpiRes<0, false, true, false>, pg8::StaticOrder, true, true>(lds, g, S, E); }
            else { pg8::EpiRes<1, false, true, false> E{nullptr, nullptr, D_MODEL, HN, p.in[24] + l * D_MODEL, SSPF, nullptr, p.in[1] + l * D_MODEL};
                pg8::gemm_phase<pg8::EpiRes<1, false, true, false>, pg8::StaticOrder, true, true>(lds, g, S, E); }
        } else if (sub == 5) {
            for (int st_ = 0; st_ < ((bx >> 3) & 3) * STAGGER_UP; ++st_) __builtin_amdgcn_s_sleep(8);
            pg8::Gemm g{HN, (const bf16*)(wt + WT_UP), M_TOK, D_FF, D_MODEL}; pg8::StaticOrder S; S.init(M_TOK, D_FF, G, bx);
            pg8::EpiBf16<1, false> E{HB, D_FF, nullptr};
            pg8::gemm_phase<pg8::EpiBf16<1, false>, pg8::StaticOrder, true, true>(lds, g, S, E);
        } else if (sub == 6) {
            pg8::Gemm g{HB, (const bf16*)(wt + WT_DOWN), M_TOK, D_MODEL, D_FF}; pg8::StaticOrder S; S.init(M_TOK, D_MODEL, G, bx);
            if (l + 1 < DEPTH) { pg8::EpiRes<1, false, true, true> E{nullptr, nullptr, D_MODEL, HN, p.in[1] + (l + 1) * D_MODEL, SSP, SSPF, p.in[24] + l * D_MODEL};
                pg8::gemm_phase<pg8::EpiRes<1, false, true, true>, pg8::StaticOrder, true, true>(lds, g, S, E); }
            else { pg8::EpiRes<1, true, false, true> E{p.out, nullptr, D_MODEL, HN, nullptr, nullptr, SSPF, p.in[24] + l * D_MODEL};
                pg8::gemm_phase<pg8::EpiRes<1, true, false, true>, pg8::StaticOrder, true, true>(lds, g, S, E); }
        }
        else if (sub == 1) {
            RwkvP W;
            W.mu = p.in[9] + l * RW_W; W.w0 = p.in[10] + l * 512; W.w2 = p.in[11] + (size_t)l * 64 * 512; W.a0 = p.in[12] + l * 512; W.a2 = p.in[13] + (size_t)l * 64 * 512;
            W.g2 = p.in[14] + (size_t)l * 128 * 512; W.k_k = p.in[15] + l * 512; W.k_a = p.in[16] + l * 512; W.r_k = p.in[17] + l * 512;
            W.v0 = p.in[20]; W.v1 = p.in[21]; W.v2 = p.in[22]; W.lora = (const v4u*)(ws + WS_LORA) + (size_t)l * 6 * 2048;
            for (int tt = bx; tt < M_TOK / 32; tt += G) prep_tile(lds, tt, tid, PROJ, p.in[3] + l * 3 * 512, W, l, (float*)(ws + WS_SCAN), (float*)((unsigned char*)p.out + OUT_SC2), (float*)(ws + WS_VFIRST), MIX);
        }
        else if (sub == 2) {
            float* scanb = (float*)(ws + WS_SCAN); const size_t SB = (size_t)M_TOK * 512;
            if (bx < N_SCAN_WG) for (int rep_ = 0; rep_ < REP_SCAN; ++rep_) chain_wg(lds, bx, (const unsigned char*)scanb, scanb + 8 * SB, tid);
            else for (int pass = 0; pass < 2; ++pass) {
                if ((((bx - N_SCAN_WG) ^ pass) & 1) == 0) {
                    for (int rep_ = 0; rep_ < REP_ATT; ++rep_) attn_wg(lds, bx - N_SCAN_WG, G - N_SCAN_WG, (G - N_SCAN_WG) % 8 == 0, PROJ, p.in[4] + l * 64, p.in[5] + l * 64, p.in[6] + l * 8, p.in[7] + l * 64, p.in[8] + l * 64, p.in[27], MIX, (bf16*)((unsigned char*)p.out + OUT_DILO), (float*)((unsigned char*)p.out + OUT_DILL), tid);
                    __syncthreads();
                } else {
                    conv_job(p, ws, l, (G == 256) ? CJ_EARLY : 0, CJ_TOTAL + ((l + 1 < DEPTH) ? (D_MODEL / 64) * (IN_W / 32) : 0), (bx - N_SCAN_WG) * NWAVES + wave, (G - N_SCAN_WG) * NWAVES, (LAS float*)(lds + wave * 16384), lane);
                    __syncthreads();
                }
            }
        } else if (sub == 3) {
            float* scanb = (float*)(ws + WS_SCAN); const size_t SB = (size_t)M_TOK * 512;
            for (int m = gw; m < M_TOK; m += NGW) post_token((size_t)m, lane, scanb + 8 * SB, (const bf16*)(scanb + 6 * SB), (const bf16*)(scanb + 5 * SB), (const float*)((unsigned char*)p.out + OUT_SC2), p.in[18] + l * 512, p.in[19] + l * 512, (const bf16*)((unsigned char*)p.out + OUT_DILO), (const float*)((unsigned char*)p.out + OUT_DILL), MIX);
        }
    }
}

static void launch_range(const Params& base, int lo, int hi, int grid, hipStream_t stream) {
    Params p = base; p.ph_lo = lo; p.ph_hi = hi;
    if (hi - lo > 1) { void* args[] = {&p}; hipError_t e = hipLaunchCooperativeKernel((void*)mk_fwd, dim3(grid), dim3(NWAVES * 64), args, LDS_BYTES, stream);
        if (e != hipSuccess) fprintf(stderr, "cooperative launch failed: %s (grid %d)\n", hipGetErrorString(e), grid); }
    else hipLaunchKernelGGL(mk_fwd, dim3(grid), dim3(NWAVES * 64), LDS_BYTES, stream, p);
}
extern "C" void kernel_launch(void* const* d_in, const int* in_sizes, int n_in, void* d_out, int out_size, void* d_ws, size_t ws_size, hipStream_t stream) {
    static int grid = 0;
    if (grid == 0) {
        if (ws_size < WS_END || n_in != 28 || out_size != M_TOK * D_MODEL) { fprintf(stderr, "kernel_launch: unexpected sizes (ws %zu)\n", ws_size); grid = -1; return; }
        int dev = 0, cus = 0, per_cu = 0;
        hipGetDevice(&dev); hipDeviceGetAttribute(&cus, hipDeviceAttributeMultiprocessorCount, dev);
        hipFuncSetAttribute((const void*)mk_fwd, hipFuncAttributeMaxDynamicSharedMemorySize, LDS_BYTES);
        hipOccupancyMaxActiveBlocksPerMultiprocessor(&per_cu, (const void*)mk_fwd, NWAVES * 64, LDS_BYTES);
        if (per_cu < 1) { fprintf(stderr, "kernel_launch: occupancy query says %d blocks per CU\n", per_cu); grid = -1; return; }
        grid = cus;
    }
    if (grid < 0) return;
    Params P{};
    for (int i = 0; i < 28; ++i) P.in[i] = (const float*)d_in[i];
    P.out = (float*)d_out; P.ws = (unsigned char*)d_ws;
    hipMemsetAsync((char*)d_ws + WS_CTL, 0, 65536, stream);
    launch_range(P, 0, N_PHASES, grid, stream);
}
```

```cpp
#include <hip/hip_runtime.h>
#include <cstdio>
#include <cstdint>
#include <cmath>
#ifndef REP_P1
#define REP_P1 1
#define REP_P2 1
#define REP_P3 1
#define REP_P4 1
#endif

constexpr int D_MODEL = 2048, BATCH = 4, SEQ = 2048, DEPTH = 2, HD = 64;
constexpr int M_TOK = BATCH * SEQ;
constexpr int IN_W = 5632, D_FF = 8192;
constexpr int RW_W = 1792;
constexpr int OFF_CB = 0, OFF_CC = 512, OFF_CU = 1024, OFF_SQ = 1536, OFF_SK = 2048, OFF_SV = 2176,
              OFF_DQ = 2304, OFF_DK = 2816, OFF_DV = 3328, OFF_RW = 3840;
constexpr float RMS_EPS = 1e-6f, LN_X_EPS = 64e-5f, NEGF = -1e30f;

typedef unsigned short bf16;
#define GAS __attribute__((address_space(1)))
#define LAS __attribute__((address_space(3)))
typedef unsigned v4u __attribute__((ext_vector_type(4)));
typedef float f32x4 __attribute__((ext_vector_type(4)));
typedef float f32x2 __attribute__((ext_vector_type(2)));
__device__ __forceinline__ unsigned f2bf(float f) { unsigned u = __builtin_bit_cast(unsigned, f); return (u + 0x7fffu + ((u >> 16) & 1u)) >> 16; }
typedef __bf16 bf16n2 __attribute__((ext_vector_type(2)));
__device__ __forceinline__ unsigned pk2(float lo, float hi) { const f32x2 v = {lo, hi}; return __builtin_bit_cast(unsigned, __builtin_convertvector(v, bf16n2)); }
__device__ __forceinline__ float bf2f(unsigned short b) { return __builtin_bit_cast(float, (unsigned)b << 16); }
__device__ __forceinline__ float ldv(const float* p) { return *p; }
__device__ __forceinline__ float ldv(const bf16* p) { return bf2f(*p); }
__device__ __forceinline__ void stv(float* p, float v) { *p = v; }
__device__ __forceinline__ void stv(bf16* p, float v) { *p = (bf16)f2bf(v); }

__device__ __forceinline__ float wave_sum(float v) {
#pragma unroll
    for (int o = 1; o < 64; o <<= 1) v += __shfl_xor(v, o);
    return v;
}
__device__ __forceinline__ float sigmoidf_(float x) { return 1.f / (1.f + expf(-x)); }

__device__ __forceinline__ int t5_bucket(int dist) {
    if (dist < 0) dist = 0;
    if (dist < 16) return dist;
    float scaled = logf((float)dist / 16.f) / logf(8.f);
    int large = 16 + (int)(scaled * 16.f);
    return large < 31 ? large : 31;
}

namespace pg8 {
#define PG8_LAS __attribute__((address_space(3)))
typedef unsigned short bf16_t;
typedef short bf16x8 __attribute__((ext_vector_type(8)));
typedef float f32x4 __attribute__((ext_vector_type(4)));
typedef unsigned u32x4 __attribute__((ext_vector_type(4)));
constexpr int BM = 256, BK = 64, HALF = 128, HTB = HALF * BK * 2  , STAGE_BYTES = 8 * HTB, NXCD = 8, WGM = 4;

__host__ __device__ __forceinline__ int lds_byte(int r, int c) { const int st = (r >> 4) * 2 + (c >> 5), rr = r & 15, cc = c & 31, ob = rr * 64 + cc * 2; return st * 1024 + (ob ^ (((ob >> 9) & 1) << 5)); }
__host__ __device__ __forceinline__ void stage_rc(int b, int& R, int& C) { const int st = b / 1024, sb = b % 1024, swz = sb ^ (((sb >> 9) & 1) << 5); R = (st >> 1) * 16 + swz / 64; C = (st & 1) * 32 + (swz % 64) / 2; }
__host__ __device__ __forceinline__ int perm32(int rho) { const int n = rho >> 4, i = rho & 15; return 8 * (i >> 2) + 4 * n + (i & 3); }

struct Unit { int pm, pn; };
struct Gemm { const bf16_t* A; const bf16_t* Bt; int M, N, K; };

struct StaticOrder {
    int nM, nN, nwg, G, c;
    __host__ __device__ void init(int M, int N, int G_, int c_) { nM = M / BM; nN = N / BM; nwg = nM * nN; G = G_; c = c_; }
    __host__ __device__ bool next(int i, Unit& u) const {
        const long L = (long)i * G + c; if (L >= nwg) return false;
        int wgid = (int)L; { const int q = nwg / NXCD, r = nwg % NXCD, xcd = wgid % NXCD, off = wgid / NXCD; wgid = (xcd < r ? xcd * (q + 1) : r * (q + 1) + (xcd - r) * q) + off; }
        const int nig = WGM * nN, gid = wgid / nig, fm = gid * WGM, gsz = (nM - fm) < WGM ? (nM - fm) : WGM;
        u.pm = fm + ((wgid % nig) % gsz); u.pn = (wgid % nig) / gsz; return true;
    }
    __device__ __forceinline__ void a_ready(const Unit&) const {}
    __device__ __forceinline__ void done(const Unit&) const {}
};

__device__ __forceinline__ unsigned cvt_pk_bf16(float lo, float hi) { return ::pk2(lo, hi); }
typedef float f32x2 __attribute__((ext_vector_type(2)));

template <int ACT  , bool SCALE = true> struct EpiBf16 {
    static constexpr bool PERM = true, AFTER_DRAIN = false, TOUCH = false;
    bf16_t* O; int ldc; const float* ssp;
    const PG8_LAS float* rs_lds = nullptr; int rs_pm = -1;
    __device__ __forceinline__ void operator()(const f32x4 (&acc)[2][2][4][2], const Unit& u, int wr, int wc, int fr, int fq) const {
        const int row0 = u.pm * BM + wr * 64 + fr, col0 = u.pn * BM + wc * 32 + 8 * fq;
        float rs[2][4];
#pragma unroll
        for (int ai = 0; ai < 2; ++ai)
#pragma unroll
            for (int m = 0; m < 4; ++m) { if (!SCALE) { rs[ai][m] = 1.f; continue; }
                if (u.pm == rs_pm) { const float r = rs_lds[wr * 64 + fr + ai * HALF + m * 16]; rs[ai][m] = (ACT == 1) ? r * r : r; continue; }
                const f32x4* sp = (const f32x4*)(ssp + (size_t)(row0 + ai * HALF + m * 16) * 32 + 8 * fq); const f32x4 a = sp[0], b = sp[1];
                float t = ((a[0] + a[1]) + (a[2] + a[3])) + ((b[0] + b[1]) + (b[2] + b[3]));
                t += __shfl_xor(t, 16); t += __shfl_xor(t, 32);
                const float r = __builtin_amdgcn_rsqf(t * (1.f / 2048.f) + 1e-6f); rs[ai][m] = (ACT == 1) ? r * r : r; }
#pragma unroll
        for (int ai = 0; ai < 2; ++ai)
#pragma unroll
            for (int m = 0; m < 4; ++m) { bf16_t* rowp = O + (size_t)(row0 + ai * HALF + m * 16) * ldc + col0;
#pragma unroll
                for (int bj = 0; bj < 2; ++bj) { f32x4 v0 = acc[ai][bj][m][0], v1 = acc[ai][bj][m][1];
                    if (ACT == 1) { v0 = __builtin_elementwise_max(v0, (f32x4){0.f, 0.f, 0.f, 0.f}); v1 = __builtin_elementwise_max(v1, (f32x4){0.f, 0.f, 0.f, 0.f}); v0 = v0 * v0; v1 = v1 * v1; }
                    if (SCALE) { v0 = v0 * rs[ai][m]; v1 = v1 * rs[ai][m]; }
                    u32x4 w; w.x = cvt_pk_bf16(v0[0], v0[1]); w.y = cvt_pk_bf16(v0[2], v0[3]); w.z = cvt_pk_bf16(v1[0], v1[1]); w.w = cvt_pk_bf16(v1[2], v1[3]);
                    *(u32x4*)(rowp + bj * HALF) = w; } }
    }
};
template <int RMODE, bool WRITEC, bool NORM, bool INSCALE> struct EpiRes {
    static constexpr bool PERM = true, AFTER_DRAIN = false, TOUCH = (RMODE == 1);
    float* C; const float* R; int ldc; bf16_t* HN; const float* gW; float* ssp; const float* ssp_in; const float* gR;
    __device__ __forceinline__ void touch(const Unit& u, int tid, PG8_LAS unsigned char* dummy) const {
#pragma unroll
        for (int k = 0; k < 2; ++k) { const int ln = tid + 512 * k;
            __builtin_amdgcn_global_load_lds((const unsigned*)(HN + (size_t)(u.pm * BM + (ln >> 2)) * ldc + u.pn * BM + (ln & 3) * 64), (PG8_LAS unsigned*)dummy, 4, 0, 0); }
    }
    __device__ __forceinline__ void operator()(const f32x4 (&acc)[2][2][4][2], const Unit& u, int wr, int wc, int fr, int fq) const {
        const int row0 = u.pm * BM + wr * 64 + fr, col0 = u.pn * BM + wc * 32 + 8 * fq;
        f32x4 gv[2][2], gi[2][2];
#pragma unroll
        for (int bj = 0; bj < 2; ++bj)
#pragma unroll
            for (int n = 0; n < 2; ++n) {
                if (NORM) gv[bj][n] = *(const f32x4*)(gW + col0 + bj * HALF + n * 4);
                if (RMODE == 1) { const f32x4 t = *(const f32x4*)(gR + col0 + bj * HALF + n * 4); gi[bj][n] = (f32x4){__builtin_amdgcn_rcpf(t[0]), __builtin_amdgcn_rcpf(t[1]), __builtin_amdgcn_rcpf(t[2]), __builtin_amdgcn_rcpf(t[3])}; } }
#pragma unroll
        for (int ai = 0; ai < 2; ++ai)
#pragma unroll
            for (int m = 0; m < 4; ++m) { const int row = row0 + ai * HALF + m * 16; const size_t off = (size_t)row * ldc + col0; float ssq = 0.f; float sc2 = 1.f;
                if (INSCALE) { const f32x4* sp = (const f32x4*)(ssp_in + (size_t)row * 32 + 8 * fq); const f32x4 a = sp[0], b = sp[1];
                    float t = ((a[0] + a[1]) + (a[2] + a[3])) + ((b[0] + b[1]) + (b[2] + b[3])); t += __shfl_xor(t, 16); t += __shfl_xor(t, 32);
                    const float r = __builtin_amdgcn_rsqf(t * (1.f / 2048.f) + 1e-6f); sc2 = r * r; }
#pragma unroll
                for (int bj = 0; bj < 2; ++bj) { f32x4 rv[2];
                    if (RMODE == 0) { rv[0] = *(const f32x4*)(R + off + bj * HALF); rv[1] = *(const f32x4*)(R + off + bj * HALF + 4); }
                    else { const u32x4 w = *(const u32x4*)(HN + off + bj * HALF);
                        rv[0] = (f32x4){__builtin_bit_cast(float, w.x << 16), __builtin_bit_cast(float, w.x & 0xffff0000u), __builtin_bit_cast(float, w.y << 16), __builtin_bit_cast(float, w.y & 0xffff0000u)} * gi[bj][0];
                        rv[1] = (f32x4){__builtin_bit_cast(float, w.z << 16), __builtin_bit_cast(float, w.z & 0xffff0000u), __builtin_bit_cast(float, w.w << 16), __builtin_bit_cast(float, w.w & 0xffff0000u)} * gi[bj][1]; }
                    f32x4 x[2];
#pragma unroll
                    for (int n = 0; n < 2; ++n) { x[n] = INSCALE ? rv[n] + acc[ai][bj][m][n] * sc2 : rv[n] + acc[ai][bj][m][n];
                        if (WRITEC) *(f32x4*)(C + off + bj * HALF + n * 4) = x[n]; }
                    if (NORM) { ssq += ((x[0][0] * x[0][0] + x[0][1] * x[0][1]) + (x[0][2] * x[0][2] + x[0][3] * x[0][3])) + ((x[1][0] * x[1][0] + x[1][1] * x[1][1]) + (x[1][2] * x[1][2] + x[1][3] * x[1][3]));
                        const f32x4 y0 = x[0] * gv[bj][0], y1 = x[1] * gv[bj][1];
                        u32x4 o; o.x = cvt_pk_bf16(y0[0], y0[1]); o.y = cvt_pk_bf16(y0[2], y0[3]); o.z = cvt_pk_bf16(y1[0], y1[1]); o.w = cvt_pk_bf16(y1[2], y1[3]);
                        *(u32x4*)(HN + off + bj * HALF) = o; } }
                if (NORM) { ssq += __shfl_xor(ssq, 16); ssq += __shfl_xor(ssq, 32); if (fq == 0) ssp[(size_t)row * 32 + u.pn * 4 + wc] = ssq; } }
    }
};
template <class Epi, class Sched, bool ALIGN_EPI = false, bool SP2 = false>
__device__ __forceinline__ void gemm_phase(PG8_LAS unsigned char* lds, const Gemm g, const Sched& S, const Epi& E) {
    int tid_o = threadIdx.x; asm volatile("" : "+v"(tid_o));
    const int tid = tid_o, wid = __builtin_amdgcn_readfirstlane(tid >> 6), lane = tid & 63, wr = wid >> 2, wc = wid & 3, fr = lane & 15, fq = lane >> 4;
    const int K = g.K, nt = K / BK;
    unsigned voffA[2], voffB[2];
#pragma unroll
    for (int i = 0; i < 2; ++i) { int R, C; stage_rc(tid * 16 + i * 8192, R, C); const int Rb = Epi::PERM ? ((R & ~31) + perm32(R & 31)) : R;
        voffA[i] = (unsigned)(R * K + C) * 2u; voffB[i] = (unsigned)(Rb * K + C) * 2u; }
    const size_t kstep = (size_t)(BK * 2);
    const size_t hstep = (size_t)HALF * K * 2;
    const size_t tstep = 2 * hstep;
    const unsigned ldsw = (unsigned)wid * 1024u;
    const int aoff = lds_byte(wr * 64 + fr, fq * 8), boff = lds_byte(wc * 32 + fr, fq * 8);
#define PG8_SA(b, h) (((b) * 2 + (h)) * HTB)
#define PG8_SB(b, h) ((4 + (b) * 2 + (h)) * HTB)
#define PG8_STAGE(bufoff, gbase, voff) do { _Pragma("unroll") for (int _i = 0; _i < 2; ++_i) \
        __builtin_amdgcn_global_load_lds((const unsigned*)((const char*)(gbase) + (voff)[_i]), (PG8_LAS unsigned*)(lds + (bufoff) + ldsw + _i * 8192), 16, 0, 0); } while (0)
#define PG8_LDA(dst, b, h) do { _Pragma("unroll") for (int m = 0; m < 4; ++m) _Pragma("unroll") for (int k = 0; k < 2; ++k) dst[m][k] = *(const PG8_LAS bf16x8*)(lds + PG8_SA(b, h) + aoff + m * 2048 + k * 1024); } while (0)
#define PG8_LDB(dst, b, h) do { _Pragma("unroll") for (int n = 0; n < 2; ++n) _Pragma("unroll") for (int k = 0; k < 2; ++k) dst[n][k] = *(const PG8_LAS bf16x8*)(lds + PG8_SB(b, h) + boff + n * 2048 + k * 1024); } while (0)
#define PG8_MMA(ai, bj, At, Bt) do { __builtin_amdgcn_s_setprio(1); _Pragma("unroll") for (int m = 0; m < 4; ++m) _Pragma("unroll") for (int n = 0; n < 2; ++n) _Pragma("unroll") for (int k = 0; k < 2; ++k) \
        acc[ai][bj][m][n] = __builtin_amdgcn_mfma_f32_16x16x32_bf16(Bt[n][k], At[m][k], acc[ai][bj][m][n], 0, 0, 0); __builtin_amdgcn_s_setprio(0); } while (0)
#define PG8_WAIT_V(n) asm volatile("s_waitcnt vmcnt(" #n ")" ::: "memory")
#define PG8_WAIT_L(n) asm volatile("s_waitcnt lgkmcnt(" #n ")" ::: "memory")
#define PG8_BAR __builtin_amdgcn_s_barrier()
#define PG8_SCHED __builtin_amdgcn_sched_barrier(0)
    Unit cur, nxt; int ui = 0;
    if (!S.next(0, cur)) return;
    f32x4 acc[2][2][4][2];
#pragma unroll
    for (int a = 0; a < 2; ++a)
#pragma unroll
        for (int b = 0; b < 2; ++b)
#pragma unroll
            for (int m = 0; m < 4; ++m)
#pragma unroll
                for (int n = 0; n < 2; ++n) acc[a][b][m][n] = (f32x4){0.f, 0.f, 0.f, 0.f};
    bf16x8 At[4][2], B0[2][2], B1[2][2];
    const char* cA = (const char*)g.A + (size_t)cur.pm * tstep; const char* cB = (const char*)g.Bt + (size_t)cur.pn * tstep;
    S.a_ready(cur);
    if constexpr (SP2) {
        PG8_STAGE(PG8_SB(0, 0), cB, voffB); PG8_STAGE(PG8_SB(0, 1), cB + hstep, voffB); PG8_STAGE(PG8_SA(0, 0), cA, voffA); PG8_STAGE(PG8_SA(0, 1), cA + hstep, voffA);
        if (wr == 1) PG8_BAR;
        PG8_WAIT_V(2); PG8_BAR;
        PG8_STAGE(PG8_SB(1, 0), cB + kstep, voffB); PG8_STAGE(PG8_SA(1, 0), cA + kstep, voffA); PG8_STAGE(PG8_SB(1, 1), cB + hstep + kstep, voffB);
        PG8_WAIT_V(6); PG8_BAR;
    } else {
        PG8_STAGE(PG8_SB(0, 0), cB, voffB); PG8_STAGE(PG8_SA(0, 0), cA, voffA); PG8_STAGE(PG8_SB(0, 1), cB + hstep, voffB); PG8_STAGE(PG8_SA(0, 1), cA + hstep, voffA);
        if (wr == 1) PG8_BAR;
        PG8_WAIT_V(4); PG8_BAR;
        PG8_STAGE(PG8_SB(1, 0), cB + kstep, voffB); PG8_STAGE(PG8_SA(1, 0), cA + kstep, voffA); PG8_STAGE(PG8_SB(1, 1), cB + hstep + kstep, voffB);
        PG8_WAIT_V(6); PG8_BAR;
    }
    for (;;) {
        const bool has_next = S.next(ui + 1, nxt);
        const char* nA = has_next ? (const char*)g.A + (size_t)nxt.pm * tstep : cA; const char* nB = has_next ? (const char*)g.Bt + (size_t)nxt.pn * tstep : cB;
        for (int t = 0; t < nt; t += 2) {
            const bool last = (t == nt - 2);
            const char* a1 = cA + (size_t)(t + 1) * kstep;
            const char* a2 = last ? nA : cA + (size_t)(t + 2) * kstep; const char* b2 = last ? nB : cB + (size_t)(t + 2) * kstep;
            const char* a3 = a2 + kstep; const char* b3 = b2 + kstep;
            if (last && has_next) S.a_ready(nxt);
            if constexpr (Epi::TOUCH) { if (t == nt - 4) E.touch(cur, tid, lds + STAGE_BYTES + 2048 + ldsw / 4); }
            if constexpr (SP2) {
            PG8_LDB(B0, 0, 0); PG8_LDB(B1, 0, 1); PG8_SCHED; PG8_LDA(At, 0, 0); PG8_STAGE(PG8_SA(1, 1), a1 + hstep, voffA);
            PG8_WAIT_V(8); PG8_WAIT_L(0); PG8_BAR; PG8_MMA(0, 0, At, B0); PG8_MMA(0, 1, At, B1); PG8_BAR; PG8_SCHED;
            PG8_LDA(At, 0, 1); PG8_STAGE(PG8_SB(0, 0), b2, voffB); PG8_STAGE(PG8_SB(0, 1), b2 + hstep, voffB); PG8_STAGE(PG8_SA(0, 0), a2, voffA);
            PG8_WAIT_V(8); PG8_WAIT_L(0); PG8_BAR; PG8_MMA(1, 0, At, B0); PG8_MMA(1, 1, At, B1); PG8_BAR; PG8_SCHED;
            PG8_LDB(B0, 1, 0); PG8_LDB(B1, 1, 1); PG8_SCHED; PG8_LDA(At, 1, 0); PG8_STAGE(PG8_SA(0, 1), a2 + hstep, voffA);
            PG8_WAIT_V(8); PG8_WAIT_L(0); PG8_BAR; PG8_MMA(0, 0, At, B0); PG8_MMA(0, 1, At, B1); PG8_BAR; PG8_SCHED;
            PG8_LDA(At, 1, 1); PG8_STAGE(PG8_SB(1, 0), b3, voffB); PG8_STAGE(PG8_SB(1, 1), b3 + hstep, voffB); PG8_STAGE(PG8_SA(1, 0), a3, voffA);
            PG8_WAIT_V(8); PG8_WAIT_L(0); PG8_BAR; PG8_MMA(1, 0, At, B0); PG8_MMA(1, 1, At, B1); PG8_BAR; PG8_SCHED;
            } else {
            PG8_LDB(B0, 0, 0); PG8_SCHED; PG8_LDA(At, 0, 0); PG8_STAGE(PG8_SA(1, 1), a1 + hstep, voffA);
            PG8_WAIT_L(8); PG8_BAR; PG8_WAIT_L(0); PG8_MMA(0, 0, At, B0); PG8_BAR; PG8_SCHED;
            PG8_LDB(B1, 0, 1); PG8_STAGE(PG8_SB(0, 0), b2, voffB);
            PG8_BAR; PG8_WAIT_L(0); PG8_MMA(0, 1, At, B1); PG8_BAR;
            PG8_LDA(At, 0, 1); PG8_STAGE(PG8_SA(0, 0), a2, voffA);
            PG8_BAR; PG8_WAIT_L(0); PG8_MMA(1, 0, At, B0); PG8_BAR; PG8_SCHED;
            PG8_STAGE(PG8_SB(0, 1), b2 + hstep, voffB);
            PG8_WAIT_V(6); PG8_BAR; PG8_MMA(1, 1, At, B1); PG8_BAR;
            PG8_LDB(B0, 1, 0); PG8_SCHED; PG8_LDA(At, 1, 0); PG8_STAGE(PG8_SA(0, 1), a2 + hstep, voffA);
            PG8_WAIT_L(8); PG8_BAR; PG8_WAIT_L(0); PG8_MMA(0, 0, At, B0); PG8_BAR; PG8_SCHED;
            PG8_LDB(B1, 1, 1); PG8_STAGE(PG8_SB(1, 0), b3, voffB);
            PG8_BAR; PG8_WAIT_L(0); PG8_MMA(0, 1, At, B1); PG8_BAR;
            PG8_LDA(At, 1, 1); PG8_STAGE(PG8_SA(1, 0), a3, voffA);
            PG8_BAR; PG8_WAIT_L(0); PG8_MMA(1, 0, At, B0); PG8_BAR; PG8_SCHED;
            PG8_STAGE(PG8_SB(1, 1), b3 + hstep, voffB);
            PG8_WAIT_V(6); PG8_BAR; PG8_MMA(1, 1, At, B1); PG8_BAR;
            }
        }
        if constexpr (ALIGN_EPI) { if (wr == 0) PG8_BAR; }
        if constexpr (!Epi::AFTER_DRAIN) { E(acc, cur, wr, wc, fr, fq); S.done(cur); }
        if (!has_next) break;
#pragma unroll
        for (int a = 0; a < 2; ++a)
#pragma unroll
            for (int b = 0; b < 2; ++b)
#pragma unroll
                for (int m = 0; m < 4; ++m)
#pragma unroll
                    for (int n = 0; n < 2; ++n) acc[a][b][m][n] = (f32x4){0.f, 0.f, 0.f, 0.f};
        cur = nxt; cA = nA; cB = nB; ++ui;
        if constexpr (ALIGN_EPI) { if (wr == 1) PG8_BAR; }
    }
    PG8_WAIT_V(0);
    if constexpr (!ALIGN_EPI) { if (wr == 0) PG8_BAR; }
    PG8_BAR;
    if constexpr (Epi::AFTER_DRAIN) { E.fused(acc, cur, wr, wc, fr, fq, lds, wid, lane); S.done(cur); }
#undef PG8_SA
#undef PG8_SB
#undef PG8_STAGE
#undef PG8_LDA
#undef PG8_LDB
#undef PG8_MMA
#undef PG8_WAIT_V
#undef PG8_WAIT_L
#undef PG8_BAR
#undef PG8_SCHED
}
}

typedef short bf16x8_t __attribute__((ext_vector_type(8)));
typedef short s16x4_t __attribute__((ext_vector_type(4)));
template <int CTRL> __device__ __forceinline__ float dpp_f(float x) { return __builtin_bit_cast(float, __builtin_amdgcn_mov_dpp(__builtin_bit_cast(int, x), CTRL, 0xF, 0xF, true)); }
__device__ __forceinline__ float allreduce16(float p) {
    p += dpp_f<0xB1>(p);
    p += dpp_f<0x4E>(p);
    p += dpp_f<0x141>(p);
    p += dpp_f<0x140>(p);
    return p;
}
__device__ __forceinline__ float allreduce8(float p) { p += dpp_f<0xB1>(p); p += dpp_f<0x4E>(p); p += dpp_f<0x141>(p); return p; }

constexpr int AT_K = 0, AT_V = 65536, AT_Q = 131072, AT_TB = AT_Q + 16384, AT_G = AT_TB + 6400, AT_RB = AT_G + 1024, AT_SK = AT_RB + 2048, AT_RK = AT_SK + 32, AT_END = AT_RK + 1024;
constexpr int N_ATT_UNITS = 2048;
__device__ __forceinline__ int k_off(int key, int chunk) { return key * 128 + ((chunk ^ ((key >> 1) & 7)) << 4); }
__device__ __forceinline__ int v_off(int key, int chunk) { return key * 128 + ((chunk ^ (((key >> 1) & 3) << 1)) << 4); }
__device__ __forceinline__ unsigned cvtpk(float lo, float hi) { const f32x2 v = {lo, hi}; return __builtin_bit_cast(unsigned, __builtin_convertvector(v, bf16n2)); }
struct AttU { int type, b, h, r, c, j; };
__device__ __forceinline__ AttU att_decode(int u) {
    AttU a; const int ux = u >> 8, uy = u & 255, jj = uy & 15; a.type = uy >> 6; a.b = ux >> 1; a.h = (ux & 1) * 4 + ((uy >> 4) & 3);
    if (a.type <= 1) { a.r = 1; a.c = 0; a.j = jj; } else if (a.type == 2) { a.r = 4; a.c = jj & 3; a.j = jj >> 2; } else { a.r = 16; a.c = jj; a.j = 0; }
    return a;
}
__device__ __forceinline__ void att_issue_kv(LAS unsigned char* lds, int which, int buf, const AttU& a, const bf16* __restrict__ PROJ, int wave, int lane) {
    const int col = which == 0 ? (a.type == 0 ? OFF_SK + 64 * (a.h >> 2) : OFF_DK + 64 * a.h) : (a.type == 0 ? OFF_SV + 64 * (a.h >> 2) : OFF_DV + 64 * a.h);
#pragma unroll
    for (int i = 0; i < 4; ++i) {
        const int key = 8 * (4 * wave + i) + (lane >> 3), cp = lane & 7;
        int li = 128 * (a.j - 1) + key; li = li < 0 ? 0 : li;
        const bf16* rowp = PROJ + ((size_t)a.b * SEQ + a.c + a.r * li) * IN_W + col;
        const int sw = which == 0 ? (cp ^ ((key >> 1) & 7)) : (cp ^ (((key >> 1) & 3) << 1));
        __builtin_amdgcn_global_load_lds((const unsigned*)(rowp + 8 * sw), (LAS unsigned*)(lds + (which == 0 ? AT_K : AT_V) + buf * 32768 + (4 * wave + i) * 1024), 16, 0, 0);
    }
}
__device__ __forceinline__ void att_issue_q(LAS unsigned char* lds, const AttU& a, const bf16* __restrict__ PROJ, int wave, int lane) {
    const int qcol = a.type == 0 ? OFF_SQ + 64 * a.h : OFF_DQ + 64 * a.h;
#pragma unroll
    for (int i = 0; i < 2; ++i) {
        const int r = 8 * i + (lane >> 3), cp = lane & 7;
        const bf16* rowp = PROJ + ((size_t)a.b * SEQ + a.c + a.r * (128 * a.j + 16 * wave + r)) * IN_W + qcol;
        __builtin_amdgcn_global_load_lds((const unsigned*)(rowp + 8 * (cp ^ (r & 7))), (LAS unsigned*)(lds + AT_Q + (2 * wave + i) * 1024), 16, 0, 0);
    }
}
__device__ __forceinline__ void att_normq(LAS unsigned char* lds, const AttU& a, int wave, int g, int cc, bf16x8_t (&qf)[2]) {
    const LAS unsigned char* qrow = lds + AT_Q + (16 * wave + cc) * 128;
    const v4u q0 = *(const LAS v4u*)(qrow + ((g ^ (cc & 7)) << 4)), q1 = *(const LAS v4u*)(qrow + (((g + 4) ^ (cc & 7)) << 4));
    float qv[16]; float ss = 0.f;
#pragma unroll
    for (int e = 0; e < 4; ++e) { qv[2 * e] = __builtin_bit_cast(float, q0[e] << 16); qv[2 * e + 1] = __builtin_bit_cast(float, q0[e] & 0xffff0000u); qv[8 + 2 * e] = __builtin_bit_cast(float, q1[e] << 16); qv[8 + 2 * e + 1] = __builtin_bit_cast(float, q1[e] & 0xffff0000u); }
#pragma unroll
    for (int e = 0; e < 16; ++e) ss += qv[e] * qv[e];
    ss += __shfl_xor(ss, 16); ss += __shfl_xor(ss, 32);
    const float rs = rsqrtf(ss * (1.f / 64.f) + RMS_EPS) * (0.125f * 1.4426950408889634f);
    const LAS float* qg = (const LAS float*)(lds + AT_G) + (a.type == 0 ? 0 : 128);
    const f32x4 ga = *(const LAS f32x4*)(qg + 8 * g), gb = *(const LAS f32x4*)(qg + 8 * g + 4), gc = *(const LAS f32x4*)(qg + 32 + 8 * g), gd = *(const LAS f32x4*)(qg + 32 + 8 * g + 4);
    v4u x, y;
    x.x = cvtpk(qv[0] * rs * ga.x, qv[1] * rs * ga.y); x.y = cvtpk(qv[2] * rs * ga.z, qv[3] * rs * ga.w); x.z = cvtpk(qv[4] * rs * gb.x, qv[5] * rs * gb.y); x.w = cvtpk(qv[6] * rs * gb.z, qv[7] * rs * gb.w);
    y.x = cvtpk(qv[8] * rs * gc.x, qv[9] * rs * gc.y); y.y = cvtpk(qv[10] * rs * gc.z, qv[11] * rs * gc.w); y.z = cvtpk(qv[12] * rs * gd.x, qv[13] * rs * gd.y); y.w = cvtpk(qv[14] * rs * gd.z, qv[15] * rs * gd.w);
    qf[0] = __builtin_bit_cast(bf16x8_t, x); qf[1] = __builtin_bit_cast(bf16x8_t, y);
}
#define ATT_LBAR asm volatile("s_waitcnt lgkmcnt(0)\n\ts_barrier" ::: "memory")
__device__ __forceinline__ void attn_wg(LAS unsigned char* lds, int v0, int vstride, bool xmap, const bf16* __restrict__ PROJ, const float* __restrict__ qg_swa, const float* __restrict__ kg_swa, const float* __restrict__ sink_swa,
                                        const float* __restrict__ qg_dil, const float* __restrict__ kg_dil, const float* __restrict__ rel_bias, bf16* __restrict__ MIX, bf16* __restrict__ DILO, float* __restrict__ DILL, float* __restrict__ SC2, int tid) {
    if (v0 >= N_ATT_UNITS) return;
    const int wave = __builtin_amdgcn_readfirstlane(tid >> 6), lane = tid & 63, g = lane >> 4, cc = lane & 15;
    const int vlast = v0 + ((N_ATT_UNITS - 1 - v0) / vstride) * vstride;
#define ATT_UNIT(v) att_decode(xmap ? (((v) < vlast ? (v) : vlast) & 7) * 256 + (((v) < vlast ? (v) : vlast) >> 3) : ((v) < vlast ? (v) : vlast))
    AttU a = ATT_UNIT(v0), a1 = ATT_UNIT(v0 + vstride);
    att_issue_kv(lds, 0, 0, a, PROJ, wave, lane); att_issue_q(lds, a, PROJ, wave, lane); att_issue_kv(lds, 1, 0, a, PROJ, wave, lane);
    att_issue_kv(lds, 0, 1, a1, PROJ, wave, lane); att_issue_kv(lds, 1, 1, a1, PROJ, wave, lane);
    if (tid < 128) { const int w = tid >> 6, e = tid & 63; ((LAS float*)(lds + AT_G))[128 * w + e] = (w == 0 ? qg_swa[e] * kg_swa[e] : qg_dil[e] * kg_dil[e]); }
    ((LAS float*)(lds + AT_RB))[tid] = rel_bias[tid];
    if (tid < 8) ((LAS float*)(lds + AT_SK))[tid] = sink_swa[tid];
    ATT_LBAR;
    int buf = 0;
    for (int v = v0, it = 0; v < N_ATT_UNITS; v += vstride, buf ^= 1, ++it) {
        const bool swa = (a.type == 0);
        const int maxd = swa ? 127 : 128, bc = swa ? a.h : 8 + a.h;
        LAS unsigned char* const KB = lds + AT_K + buf * 32768; LAS unsigned char* const VB = lds + AT_V + buf * 32768;
        if (it == 0) asm volatile("s_waitcnt vmcnt(0)" ::: "memory"); else asm volatile("s_waitcnt vmcnt(13)" ::: "memory");
        bf16x8_t qf[2];
        att_normq(lds, a, wave, g, cc, qf);
        {
#pragma unroll
            for (int tt = 0; tt < 2; ++tt) {
                const int key = 32 * wave + 16 * tt + cc;
                const bf16x8_t k0 = *(const LAS bf16x8_t*)(KB + k_off(key, g)), k1 = *(const LAS bf16x8_t*)(KB + k_off(key, g + 4));
                f32x4 d = __builtin_amdgcn_mfma_f32_16x16x32_bf16(k0, k0, (f32x4){0.f, 0.f, 0.f, 0.f}, 0, 0, 0);
                d = __builtin_amdgcn_mfma_f32_16x16x32_bf16(k1, k1, d, 0, 0, 0);
                const int di = cc & 3;
                const float ss = di == 0 ? d[0] : di == 1 ? d[1] : di == 2 ? d[2] : d[3];
                if ((cc >> 2) == g) ((LAS float*)(lds + AT_RK))[key] = rsqrtf(ss * (1.f / 64.f) + RMS_EPS);
            }
            if (tid < 384) { const int dist = 255 - tid; float val = NEGF; if (dist >= 0 && dist <= maxd) val = 1.4426950408889634f * ((const LAS float*)(lds + AT_RB))[t5_bucket(dist * a.r) * 16 + bc];
#pragma unroll
                for (int sft = 0; sft < 4; ++sft) if (tid >= sft) ((LAS float*)(lds + AT_TB))[sft * 400 + tid - sft] = val; }
        }
        ATT_LBAR;
        const AttU an = ATT_UNIT(v + vstride), an2 = ATT_UNIT(v + 2 * vstride);
        att_issue_q(lds, an, PROJ, wave, lane);
        const int n0 = wave & ~1;
        const int nlo = (a.j == 0 && n0 < 8) ? 8 - n0 : 0;
        f32x4 sc[10];
        {
            bf16x8_t kfa[10], kfb[10];
#pragma unroll
            for (int nn = 0; nn < 10; ++nn) { const int key = 16 * (n0 + nn) + cc; kfa[nn] = *(const LAS bf16x8_t*)(KB + k_off(key, g)); kfb[nn] = *(const LAS bf16x8_t*)(KB + k_off(key, g + 4)); }
            __builtin_amdgcn_sched_barrier(0);
#pragma unroll
            for (int nn = 0; nn < 10; ++nn) {
                f32x4 acc = (f32x4){0.f, 0.f, 0.f, 0.f};
                if (nn >= nlo) {
                    acc = __builtin_amdgcn_mfma_f32_16x16x32_bf16(kfa[nn], qf[0], acc, 0, 0, 0);
                    acc = __builtin_amdgcn_mfma_f32_16x16x32_bf16(kfb[nn], qf[1], acc, 0, 0, 0);
                }
                sc[nn] = acc;
            }
        }
        asm volatile("s_waitcnt vmcnt(17)" ::: "memory");
        ATT_LBAR;
        att_issue_kv(lds, 0, buf, an2, PROJ, wave, lane);
        const int ib = 4 * g - 16 * wave - cc + 127;
        const LAS float* tb = (const LAS float*)(lds + AT_TB) + (ib & 3) * 400 + (ib & ~3) + 16 * n0;
        const float sink = swa ? 1.4426950408889634f * ((const LAS float*)(lds + AT_SK))[a.h] : NEGF;
        const LAS float* rkp = (const LAS float*)(lds + AT_RK) + 16 * n0 + 4 * g;
        float m = NEGF;
#pragma unroll
        for (int nn = 0; nn < 10; ++nn) {
            if (nn < nlo) sc[nn] = (f32x4){NEGF, NEGF, NEGF, NEGF};
            else { const f32x4 bv = *(const LAS f32x4*)(tb + 16 * nn), rk = *(const LAS f32x4*)(rkp + 16 * nn);
#pragma unroll
                for (int i = 0; i < 4; ++i) { const float sv = fmaf(sc[nn][i], rk[i], bv[i]); sc[nn][i] = sv; m = fmaxf(m, sv); } }
        }
        m = fmaxf(m, __shfl_xor(m, 16)); m = fmaxf(m, __shfl_xor(m, 32));
        m = fmaxf(m, sink);
        float l = 0.f;
#pragma unroll
        for (int nn = 0; nn < 10; ++nn)
#pragma unroll
            for (int i = 0; i < 4; ++i) { const float pv = __builtin_amdgcn_exp2f(sc[nn][i] - m); sc[nn][i] = pv; l += pv; }
        l += __shfl_xor(l, 16); l += __shfl_xor(l, 32);
        l += __builtin_amdgcn_exp2f(sink - m);
        f32x4 oa[4];
#pragma unroll
        for (int m4 = 0; m4 < 4; ++m4) oa[m4] = (f32x4){0.f, 0.f, 0.f, 0.f};
        const int tq_ = (cc >> 2), tp_ = cc & 3;
#pragma unroll
        for (int pp = 0; pp < 5; ++pp) if (2 * pp >= nlo) {
            v4u pw; pw.x = cvtpk(sc[2 * pp][0], sc[2 * pp][1]); pw.y = cvtpk(sc[2 * pp][2], sc[2 * pp][3]); pw.z = cvtpk(sc[2 * pp + 1][0], sc[2 * pp + 1][1]); pw.w = cvtpk(sc[2 * pp + 1][2], sc[2 * pp + 1][3]);
            const bf16x8_t pf = __builtin_bit_cast(bf16x8_t, pw);
            const int kb0 = 16 * (n0 + 2 * pp) + 4 * g + tq_, kb1 = kb0 + 16;
#pragma unroll
            for (int m4 = 0; m4 < 4; ++m4) {
                const s16x4_t lo = __builtin_bit_cast(s16x4_t, __builtin_amdgcn_ds_read_tr16_b64_v4i16((LAS s16x4_t*)(VB + v_off(kb0, 2 * m4 + (tp_ >> 1)) + (tp_ & 1) * 8)));
                const s16x4_t hi = __builtin_bit_cast(s16x4_t, __builtin_amdgcn_ds_read_tr16_b64_v4i16((LAS s16x4_t*)(VB + v_off(kb1, 2 * m4 + (tp_ >> 1)) + (tp_ & 1) * 8)));
                const bf16x8_t vf = (bf16x8_t){lo[0], lo[1], lo[2], lo[3], hi[0], hi[1], hi[2], hi[3]};
                oa[m4] = __builtin_amdgcn_mfma_f32_16x16x32_bf16(vf, pf, oa[m4], 0, 0, 0);
            }
        }
        const float inv = 1.f / l;
        const size_t tok = (size_t)a.b * SEQ + a.c + a.r * (128 * a.j + 16 * wave + cc);
        bf16* const orow = swa ? MIX + tok * D_MODEL + 512 + 64 * a.h : DILO + ((size_t)(a.type - 1) * M_TOK + tok) * 512 + 64 * a.h;
#pragma unroll
        for (int m4 = 0; m4 < 4; ++m4) {
            const unsigned w0 = cvtpk(oa[m4][0] * inv, oa[m4][1] * inv), w1 = cvtpk(oa[m4][2] * inv, oa[m4][3] * inv);
            *(unsigned long long*)(orow + 16 * m4 + 4 * g) = (unsigned long long)w0 | ((unsigned long long)w1 << 32);
        }
        float* const lrow = swa ? SC2 + (tok * 8 + a.h) * 4 + 3 : DILL + ((size_t)(a.type - 1) * M_TOK + tok) * 8 + a.h;
        if (g == 0) *lrow = (m + __log2f(l)) * 0.6931471805599453f;
        ATT_LBAR;
        att_issue_kv(lds, 1, buf, an2, PROJ, wave, lane);
        a = an;
    }
#undef ATT_UNIT
    asm volatile("s_waitcnt vmcnt(0)" ::: "memory");
    __syncthreads();
}

__device__ __forceinline__ void unpack8(const v4u w, float (&o)[8]) {
#pragma unroll
    for (int e = 0; e < 4; ++e) { o[2 * e] = __builtin_bit_cast(float, w[e] << 16); o[2 * e + 1] = __builtin_bit_cast(float, w[e] & 0xffff0000u); }
}
__device__ __forceinline__ void unpack4(const unsigned long long w, float (&o)[4]) {
    const unsigned lo = (unsigned)w, hi = (unsigned)(w >> 32);
    o[0] = __builtin_bit_cast(float, lo << 16); o[1] = __builtin_bit_cast(float, lo & 0xffff0000u); o[2] = __builtin_bit_cast(float, hi << 16); o[3] = __builtin_bit_cast(float, hi & 0xffff0000u);
}
__device__ __forceinline__ void post_token(size_t tok, int lane, const float* __restrict__ Yb, const bf16* __restrict__ Gb, const bf16* __restrict__ Vb, const float* __restrict__ SC2, const float* __restrict__ ln_g, const float* __restrict__ ln_b,
                                           const bf16* __restrict__ DILO, const float* __restrict__ DILL, bf16* __restrict__ MIX) {
    const int c8 = 8 * lane, hh = lane >> 3;
    {
        const f32x4 y0 = *(const f32x4*)(Yb + tok * 512 + c8), y1 = *(const f32x4*)(Yb + tok * 512 + c8 + 4);
        float y[8] = {y0.x, y0.y, y0.z, y0.w, y1.x, y1.y, y1.z, y1.w};
        float sm = 0.f;
#pragma unroll
        for (int e = 0; e < 8; ++e) sm += y[e];
        const float mean = allreduce8(sm) * (1.f / 64.f);
        float sq = 0.f;
#pragma unroll
        for (int e = 0; e < 8; ++e) { y[e] -= mean; sq += y[e] * y[e]; }
        const float rstd = rsqrtf(allreduce8(sq) * (1.f / 64.f) + LN_X_EPS);
        float gg[8]; unpack8(*(const v4u*)(Gb + tok * 512 + c8), gg);
        const float bsc = SC2[(tok * 8 + hh) * 4 + 2];
        float vv8[8]; unpack8(*(const v4u*)(Vb + tok * 512 + c8), vv8);
        const f32x4 lg0 = *(const f32x4*)(ln_g + c8), lg1 = *(const f32x4*)(ln_g + c8 + 4), lb0 = *(const f32x4*)(ln_b + c8), lb1 = *(const f32x4*)(ln_b + c8 + 4);
        const float bb[8] = {vv8[0] * bsc, vv8[1] * bsc, vv8[2] * bsc, vv8[3] * bsc, vv8[4] * bsc, vv8[5] * bsc, vv8[6] * bsc, vv8[7] * bsc};
        const float lg[8] = {lg0.x, lg0.y, lg0.z, lg0.w, lg1.x, lg1.y, lg1.z, lg1.w}, lb[8] = {lb0.x, lb0.y, lb0.z, lb0.w, lb1.x, lb1.y, lb1.z, lb1.w};
        float o[8];
#pragma unroll
        for (int e = 0; e < 8; ++e) o[e] = (y[e] * rstd * lg[e] + lb[e] + bb[e]) * gg[e];
        v4u w; w.x = pk2(o[0], o[1]); w.y = pk2(o[2], o[3]); w.z = pk2(o[4], o[5]); w.w = pk2(o[6], o[7]);
        *(v4u*)(MIX + tok * D_MODEL + 1536 + c8) = w;
    }
    {
        const float l0 = DILL[((size_t)0 * M_TOK + tok) * 8 + hh], l1 = DILL[((size_t)1 * M_TOK + tok) * 8 + hh], l2 = DILL[((size_t)2 * M_TOK + tok) * 8 + hh];
        const float mx = fmaxf(l0, fmaxf(l1, l2));
        float w0 = __expf(l0 - mx), w1 = __expf(l1 - mx), w2 = __expf(l2 - mx);
        const float inv = 1.f / (w0 + w1 + w2); w0 *= inv; w1 *= inv; w2 *= inv;
        const v4u a = *(const v4u*)(DILO + ((size_t)0 * M_TOK + tok) * 512 + c8), bq = *(const v4u*)(DILO + ((size_t)1 * M_TOK + tok) * 512 + c8), cq = *(const v4u*)(DILO + ((size_t)2 * M_TOK + tok) * 512 + c8);
        v4u w;
#pragma unroll
        for (int e = 0; e < 4; ++e) {
            const float lo = w0 * __builtin_bit_cast(float, a[e] << 16) + w1 * __builtin_bit_cast(float, bq[e] << 16) + w2 * __builtin_bit_cast(float, cq[e] << 16);
            const float hi = w0 * __builtin_bit_cast(float, a[e] & 0xffff0000u) + w1 * __builtin_bit_cast(float, bq[e] & 0xffff0000u) + w2 * __builtin_bit_cast(float, cq[e] & 0xffff0000u);
            w[e] = pk2(lo, hi);
        }
        *(v4u*)(MIX + tok * D_MODEL + 1024 + c8) = w;
    }
}

constexpr int RC_AT = 0;
constexpr int RC_RT = 2304;
constexpr int RC_BKT = 4608;
constexpr int RC_VT = 9728;
constexpr int RC_GT = 12800;
constexpr int RC_MT = 14080;
constexpr int RC_NT = 14848;
constexpr int RC_GAM = 15872;
constexpr int RC_BYTES = 16128;
constexpr int RG_AT = 0, RG_RT = 2048, RG_BKT = 4096, RG_VT = 8192, RG_GT = 10240, RG_MT = 11264, RG_NT = 11776, RG_GAM = 12800, RG_BYTES = 13056, RC_PIECES = RG_BYTES / 16;
constexpr int CH_NIMG = 4;
constexpr int CH_RING = 8;
__device__ __forceinline__ void chain_dst(int pc, int& dA, int& dB) {
    if (pc < RG_BKT / 16) {
        const int rt = pc >= RG_RT / 16, pp = pc - rt * (RG_RT / 16), q = pp & 7;
        dA = (rt ? RC_RT : RC_AT) + (pp >> 3) * 144 + (q >> 2) * 64 + (2 * (q & 1)) * 16 + ((q >> 1) & 1) * 8; dB = dA + 16; return; }
    if (pc < RG_VT / 16)  { const int q = pc - RG_BKT / 16; dA = RC_BKT + (q >> 2) * 80 + (2 * (q & 1)) * 16 + ((q >> 1) & 1) * 8; dB = dA + 16; return; }
    if (pc < RG_GT / 16)  { const int q = pc - RG_VT / 16;  dA = RC_VT + (q >> 1) * 48 + (q & 1) * 16; dB = dA + 8; return; }
    if (pc < RG_MT / 16)  { const int q = pc - RG_GT / 16;  dA = RC_GT + (q >> 2) * 80 + (2 * (q & 1)) * 16 + ((q >> 1) & 1) * 8; dB = dA + 16; return; }
    if (pc < RG_NT / 16)  { const int q = pc - RG_MT / 16;  dA = RC_MT + (q >> 1) * 48 + (q & 1) * 16; dB = dA + 8; return; }
    if (pc < RG_GAM / 16) { dA = RC_NT + (pc - RG_NT / 16) * 16; dB = dA + 8; return; }
    dA = RC_GAM + (pc - RG_GAM / 16) * 16; dB = dA + 8;
}
#define CHAIN_LBAR do { asm volatile("" ::: "memory"); __builtin_amdgcn_s_waitcnt(0xC07F); __builtin_amdgcn_s_barrier(); asm volatile("" ::: "memory"); } while (0)
__device__ __forceinline__ void chain_wg(LAS unsigned char* lds, int hb, const unsigned char* __restrict__ REC, float* __restrict__ Yb, int tid) {
    asm volatile("" : "+v"(tid));
    const int b = hb >> 3, h = hb & 7;
    const int wave = __builtin_amdgcn_readfirstlane(tid >> 6), lane = tid & 63, g = lane >> 4, c = lane & 15;
    constexpr int NCK = SEQ / 16;
    const unsigned char* rec0 = REC + ((size_t)(b * NCK) * 8 + h) * RG_BYTES;
    const size_t recstep = (size_t)8 * RG_BYTES;
    if (wave >= 4) {
        const int lt = tid - 256;
        int pg[4], pdA[4], pdB[4];
#pragma unroll
        for (int k = 0; k < 4; ++k) { int pc = lt + 256 * k; pc = pc < RC_PIECES ? pc : RC_PIECES - 1; pg[k] = pc * 16; chain_dst(pc, pdA[k], pdB[k]); }
        v4u L[CH_RING][4];
#pragma unroll
        for (int s = 0; s < CH_RING; ++s)
#pragma unroll
            for (int k = 0; k < 4; ++k) L[s][k] = *(const v4u*)(rec0 + (size_t)s * recstep + pg[k]);
#pragma unroll
        for (int s = 0; s < 2; ++s) {
#pragma unroll
            for (int k = 0; k < 4; ++k) { *(LAS unsigned long long*)(lds + s * RC_BYTES + pdA[k]) = (unsigned long long)L[s][k].x | ((unsigned long long)L[s][k].y << 32); *(LAS unsigned long long*)(lds + s * RC_BYTES + pdB[k]) = (unsigned long long)L[s][k].z | ((unsigned long long)L[s][k].w << 32); }
#pragma unroll
            for (int k = 0; k < 4; ++k) L[s][k] = *(const v4u*)(rec0 + (size_t)(CH_RING + s) * recstep + pg[k]);
        }
        if (lt < 16) ((LAS unsigned*)(lds + (lt >> 2) * RC_BYTES + RC_AT + 128))[lt & 3] = 0u;
        CHAIN_LBAR;
#pragma unroll 1
        for (int ck = 0; ck < NCK; ck += CH_RING) {
#pragma unroll
            for (int q = 0; q < CH_RING; ++q) {
                const int cc = ck + q, s = (q + 2) % CH_RING, img = ((q + 2) % CH_NIMG) * RC_BYTES;
#pragma unroll
                for (int k = 0; k < 4; ++k) { *(LAS unsigned long long*)(lds + img + pdA[k]) = (unsigned long long)L[s][k].x | ((unsigned long long)L[s][k].y << 32); *(LAS unsigned long long*)(lds + img + pdB[k]) = (unsigned long long)L[s][k].z | ((unsigned long long)L[s][k].w << 32); }
                const int nx = (cc + 2 + CH_RING < NCK) ? cc + 2 + CH_RING : NCK - 1;
#pragma unroll
                for (int k = 0; k < 4; ++k) L[s][k] = *(const v4u*)(rec0 + (size_t)nx * recstep + pg[k]);
                CHAIN_LBAR;
            }
        }
    } else {
        f32x4 ST[4];
#pragma unroll
        for (int kt = 0; kt < 4; ++kt) ST[kt] = (f32x4){0.f, 0.f, 0.f, 0.f};
        const f32x4 z4 = (f32x4){0.f, 0.f, 0.f, 0.f};
        float* ybase = Yb + (size_t)b * SEQ * 512 + 64 * h + 16 * wave; const int yoff = 4 * g * 512 + c;
        const int oA = RC_AT + c * 144 + g * 16, oR = RC_RT + c * 144 + g * 16, oBK = RC_BKT + c * 80 + g * 16, oG = RC_GT + c * 80 + g * 16;
        const int oM = (g < 2) ? RC_MT + c * 48 + g * 16 : RC_AT + 128, oV16 = RC_VT + (16 * wave + c) * 48 + (g & 1) * 16, oV8 = RC_VT + (16 * wave + c) * 48 + g * 8, oT = RC_NT + c * 64 + g * 16, oGam = RC_GAM + g * 16;
        struct Ops { bf16x8_t aA0, aA1, aR0, aR1, am, bv, ag, abk[4]; f32x4 tt, gm[4]; unsigned long long vfr; };
#define CHAIN_READ_A(O, in) do {                                       \
            O.aA0 = *(const LAS bf16x8_t*)((in) + oA); O.aA1 = *(const LAS bf16x8_t*)((in) + oA + 64); O.am = *(const LAS bf16x8_t*)((in) + oM); O.bv = *(const LAS bf16x8_t*)((in) + oV16); O.tt = *(const LAS f32x4*)((in) + oT); } while (0)
#define CHAIN_READ_B(O, in) do {                                       \
            O.aR0 = *(const LAS bf16x8_t*)((in) + oR); O.aR1 = *(const LAS bf16x8_t*)((in) + oR + 64); O.vfr = *(const LAS unsigned long long*)((in) + oV8); O.ag = *(const LAS bf16x8_t*)((in) + oG); } while (0)
#define CHAIN_READ_C(O, in) do {                                       \
            _Pragma("unroll") for (int kt = 0; kt < 4; ++kt) O.abk[kt] = *(const LAS bf16x8_t*)((in) + oBK + kt * 16 * 80); } while (0)
#define CHAIN_READ_D(O, in) do {                                       \
            _Pragma("unroll") for (int kt = 0; kt < 4; ++kt) O.gm[kt] = *(const LAS f32x4*)((in) + oGam + kt * 64); } while (0)
#define CHAIN_READ(O, in) do { CHAIN_READ_A(O, in); CHAIN_READ_B(O, in); CHAIN_READ_C(O, in); CHAIN_READ_D(O, in); } while (0)
        CHAIN_LBAR;
        Ops opA, opB; CHAIN_READ(opA, lds);
        __builtin_amdgcn_s_waitcnt(0xC07F);
#define CHAIN_STEP(cur, nxt, cc, IMGN) do { \
            CHAIN_READ_A(nxt, lds + (IMGN) * RC_BYTES);                \
            __builtin_amdgcn_sched_barrier(0); \
              \
            v4u s0, s1; \
            s0.x = cvtpk(ST[0][0], ST[0][1]); s0.y = cvtpk(ST[0][2], ST[0][3]); s0.z = cvtpk(ST[1][0], ST[1][1]); s0.w = cvtpk(ST[1][2], ST[1][3]); \
            s1.x = cvtpk(ST[2][0], ST[2][1]); s1.y = cvtpk(ST[2][2], ST[2][3]); s1.z = cvtpk(ST[3][0], ST[3][1]); s1.w = cvtpk(ST[3][2], ST[3][3]); \
            const bf16x8_t bS0 = __builtin_bit_cast(bf16x8_t, s0), bS1 = __builtin_bit_cast(bf16x8_t, s1); \
              \
            const f32x4 xv = __builtin_amdgcn_mfma_f32_16x16x32_bf16(cur.am, cur.bv, z4, 0, 0, 0), xa = __builtin_amdgcn_mfma_f32_16x16x32_bf16(cur.aA0, bS0, z4, 0, 0, 0), xb = __builtin_amdgcn_mfma_f32_16x16x32_bf16(cur.aA1, bS1, z4, 0, 0, 0); \
            f32x4 xr = __builtin_amdgcn_mfma_f32_16x16x32_bf16(cur.aR0, bS0, z4, 0, 0, 0); \
            __builtin_amdgcn_sched_barrier(0); \
            CHAIN_READ_B(nxt, lds + (IMGN) * RC_BYTES); \
            __builtin_amdgcn_sched_barrier(0); \
            xr = __builtin_amdgcn_mfma_f32_16x16x32_bf16(cur.aR1, bS1, xr, 0, 0, 0); \
            const f32x4 x = xa + xb + xv; \
              \
            f32x4 ua = __builtin_amdgcn_mfma_f32_16x16x4f32(cur.tt[0], x[0], z4, 0, 0, 0), ub = __builtin_amdgcn_mfma_f32_16x16x4f32(cur.tt[1], x[1], z4, 0, 0, 0); \
            ua = __builtin_amdgcn_mfma_f32_16x16x4f32(cur.tt[2], x[2], ua, 0, 0, 0); ub = __builtin_amdgcn_mfma_f32_16x16x4f32(cur.tt[3], x[3], ub, 0, 0, 0); \
            __builtin_amdgcn_sched_barrier(0); \
            CHAIN_READ_C(nxt, lds + (IMGN) * RC_BYTES); \
            __builtin_amdgcn_sched_barrier(0); \
            const f32x4 u = ua + ub; \
            v4u uvw; uvw.x = cvtpk(u[0], u[1]); uvw.y = cvtpk(u[2], u[3]); uvw.z = (unsigned)cur.vfr; uvw.w = (unsigned)(cur.vfr >> 32);            \
            const bf16x8_t bUV = __builtin_bit_cast(bf16x8_t, uvw); \
              \
            _Pragma("unroll") for (int kt = 0; kt < 4; ++kt) ST[kt] = __builtin_amdgcn_mfma_f32_16x16x32_bf16(cur.abk[kt], bUV, ST[kt] * cur.gm[kt], 0, 0, 0); \
            const f32x4 y = __builtin_amdgcn_mfma_f32_16x16x32_bf16(cur.ag, bUV, xr, 0, 0, 0); \
            __builtin_amdgcn_sched_barrier(0); \
            CHAIN_READ_D(nxt, lds + (IMGN) * RC_BYTES); \
            { float* yc = ybase + (size_t)(16 * (cc)) * 512; _Pragma("unroll") for (int i = 0; i < 4; ++i) yc[yoff + i * 512] = y[i]; } \
            CHAIN_LBAR; \
        } while (0)
#pragma unroll 1
        for (int cc = 0; cc < NCK; cc += 4) { CHAIN_STEP(opA, opB, cc, 1); CHAIN_STEP(opB, opA, cc + 1, 2); CHAIN_STEP(opA, opB, cc + 2, 3); CHAIN_STEP(opB, opA, cc + 3, 0); }
#undef CHAIN_STEP
#undef CHAIN_READ_A
#undef CHAIN_READ_B
#undef CHAIN_READ_C
#undef CHAIN_READ_D
#undef CHAIN_READ
    }
    __syncthreads();
}

struct RwkvP { const float *mu, *w0, *w2, *a0, *a2, *g2, *k_k, *k_a, *r_k, *v0, *v1, *v2; const v4u* lora; };
constexpr int PR_XA = 0;
constexpr int PR_VT = 21248;
constexpr int PR_UP = 58112;
constexpr int PR_U = 135168;
constexpr int PD_TA = 0, PD_TR = 2304, PD_TB = 4608, PD_TK = 6912, PD_TV = 9216, PD_TG = 11520, PD_NT = 11776  , PD_WAVE = 12800, PD_STASH = 8 * PD_WAVE;
__device__ __forceinline__ bf16x8_t pack8(const float (&x)[8]) { v4u w; w.x = cvtpk(x[0], x[1]); w.y = cvtpk(x[2], x[3]); w.z = cvtpk(x[4], x[5]); w.w = cvtpk(x[6], x[7]); return __builtin_bit_cast(bf16x8_t, w); }
__device__ __forceinline__ float fsigmoid(float x) { return 1.f / (1.f + __expf(-x)); }

__device__ __forceinline__ void shifted4(const bf16* __restrict__ colp  , int tl0, bool first, const f32x4 mu, float (&out)[4][4]) {
    float rows[5][4];
#pragma unroll
    for (int ii = 0; ii < 5; ++ii) {
        const int tl = tl0 - 1 + ii;
        if (tl < 0 && first) { rows[ii][0] = 0.f; rows[ii][1] = 0.f; rows[ii][2] = 0.f; rows[ii][3] = 0.f; }
        else unpack4(*(const unsigned long long*)(colp + (ptrdiff_t)tl * IN_W), rows[ii]);
    }
#pragma unroll
    for (int i = 0; i < 4; ++i)
#pragma unroll
        for (int e = 0; e < 4; ++e) out[i][e] = rows[i + 1][e] + (rows[i][e] - rows[i + 1][e]) * mu[e];
}

__device__ __forceinline__ void prep_tile(LAS unsigned char* lds, int tt, int tid, const bf16* __restrict__ PROJ, const float* __restrict__ cw, const RwkvP& W, int layer,
                                          float* __restrict__ scanb, float* __restrict__ sc2, float* __restrict__ vfirst, bf16* __restrict__ MIX) {
    unsigned char* recs = (unsigned char*)scanb;
    asm volatile("" : "+v"(tid));
    const int wave = __builtin_amdgcn_readfirstlane(tid >> 6), lane = tid & 63, g = lane >> 4, c = lane & 15, h = wave;
    const int tok0 = tt * 32; const bool first = (tok0 % SEQ) == 0;
    for (int rp_ = 0; rp_ < REP_P1; ++rp_) {
        const int ti = tid >> 4, t = (tok0 + ti) % SEQ;
        const bf16* row = PROJ + (size_t)(tok0 + ti) * IN_W;
        const v4u z4u = (v4u){0u, 0u, 0u, 0u};
        v4u Lb[4], Lc0[4], Lu0[4], Lc1[4], Lu1[4], Lc2[4], Lu2[4];
        v4u yo[4]; f32x4 cwv[4][6];
#pragma unroll
        for (int qq = 0; qq < 4; ++qq) { const int ch8 = ((tid & 15) + 16 * qq) * 8;
            Lb[qq] = *(const v4u*)(row + OFF_CB + ch8); Lc0[qq] = *(const v4u*)(row + OFF_CC + ch8); Lu0[qq] = *(const v4u*)(row + OFF_CU + ch8);
            Lc1[qq] = (t >= 1) ? *(const v4u*)(row - IN_W + OFF_CC + ch8) : z4u; Lu1[qq] = (t >= 1) ? *(const v4u*)(row - IN_W + OFF_CU + ch8) : z4u;
            Lc2[qq] = (t >= 2) ? *(const v4u*)(row - 2 * IN_W + OFF_CC + ch8) : z4u; Lu2[qq] = (t >= 2) ? *(const v4u*)(row - 2 * IN_W + OFF_CU + ch8) : z4u;
#pragma unroll
            for (int kk = 0; kk < 3; ++kk) { cwv[qq][2 * kk] = *(const f32x4*)(cw + 512 * kk + ch8); cwv[qq][2 * kk + 1] = *(const f32x4*)(cw + 512 * kk + ch8 + 4); } }
#pragma unroll
        for (int qq = 0; qq < 4; ++qq) {
            const int ch8 = ((tid & 15) + 16 * qq) * 8;
            float cb[8], c0[8], u0[8], c1[8], u1[8], c2[8], u2[8];
            unpack8(Lb[qq], cb); unpack8(Lc0[qq], c0); unpack8(Lu0[qq], u0); unpack8(Lc1[qq], c1); unpack8(Lu1[qq], u1); unpack8(Lc2[qq], c2); unpack8(Lu2[qq], u2);
            float y[8];
#pragma unroll
            for (int e = 0; e < 8; ++e) y[e] = cb[e] * (cwv[qq][e >> 2][e & 3] * (c2[e] * u2[e]) + cwv[qq][2 + (e >> 2)][e & 3] * (c1[e] * u1[e]) + cwv[qq][4 + (e >> 2)][e & 3] * (c0[e] * u0[e]));
            yo[qq] = __builtin_bit_cast(v4u, pack8(y));
        }
#pragma unroll
        for (int qq = 0; qq < 4; ++qq) *(v4u*)(MIX + (size_t)(tok0 + ti) * D_MODEL + ((tid & 15) + 16 * qq) * 8) = yo[qq];
    }
    {
        const int ti = tid >> 4, cq = tid & 15, t = (tok0 + ti) % SEQ;
        const bf16* rp = PROJ + (size_t)(tok0 + ti) * IN_W + OFF_RW + 1536 + 16 * cq;
        float cur[16], prv[16];
        unpack8(*(const v4u*)rp, *(float(*)[8])&cur[0]); unpack8(*(const v4u*)(rp + 8), *(float(*)[8])&cur[8]);
        if (t > 0) { unpack8(*(const v4u*)(rp - IN_W), *(float(*)[8])&prv[0]); unpack8(*(const v4u*)(rp - IN_W + 8), *(float(*)[8])&prv[8]); }
        else {
#pragma unroll
            for (int e = 0; e < 16; ++e) prv[e] = 0.f; }
        float x[16];
#pragma unroll
        for (int e = 0; e < 16; ++e) x[e] = cur[e] + (prv[e] - cur[e]) * W.mu[1536 + 16 * cq + e];
        if (cq < 4) {
#pragma unroll
            for (int e = 0; e < 16; ++e) x[e] = 1.f - 2.f / (1.f + __expf(2.f * x[e]));
        } else if (cq >= 8) {
#pragma unroll
            for (int e = 0; e < 16; ++e) x[e] = fsigmoid(x[e]); }
        LAS unsigned char* xa = lds + PR_XA + ti * 528 + 16 * cq * 2;
        *(LAS bf16x8_t*)xa = pack8(*(float(*)[8])&x[0]); *(LAS bf16x8_t*)(xa + 16) = pack8(*(float(*)[8])&x[8]);
    }
    __syncthreads();
    const int ch = 64 * h + 4 * c;
    const size_t SB = (size_t)M_TOK * 512;
    f32x4 decr[2][4];
    for (int rp_ = 0; rp_ < REP_P2; ++rp_) {
        f32x4 az[2][4];
#pragma unroll
        for (int mt = 0; mt < 2; ++mt)
#pragma unroll
            for (int nt = 0; nt < 4; ++nt) az[mt][nt] = (f32x4){0.f, 0.f, 0.f, 0.f};
#pragma unroll
        for (int ks = 0; ks < 2; ++ks) {
            f32x4 bw[8];
#pragma unroll
            for (int jx = 0; jx < 8; ++jx) bw[jx] = *(const f32x4*)(W.w2 + (size_t)(32 * ks + 8 * g + jx) * 512 + 64 * h + 4 * c);
            const bf16x8_t af0 = *(const LAS bf16x8_t*)(lds + PR_XA + c * 528 + (32 * ks + 8 * g) * 2), af1 = *(const LAS bf16x8_t*)(lds + PR_XA + (16 + c) * 528 + (32 * ks + 8 * g) * 2);
#pragma unroll
            for (int nt = 0; nt < 4; ++nt) {
                const float col[8] = {bw[0][nt], bw[1][nt], bw[2][nt], bw[3][nt], bw[4][nt], bw[5][nt], bw[6][nt], bw[7][nt]};
                const bf16x8_t bf = pack8(col);
                az[0][nt] = __builtin_amdgcn_mfma_f32_16x16x32_bf16(af0, bf, az[0][nt], 0, 0, 0); az[1][nt] = __builtin_amdgcn_mfma_f32_16x16x32_bf16(af1, bf, az[1][nt], 0, 0, 0);
            }
        }
        const f32x4 w0v = *(const f32x4*)(W.w0 + ch);
#pragma unroll
        for (int mt = 0; mt < 2; ++mt)
#pragma unroll
            for (int i = 0; i < 4; ++i) {
#pragma unroll
                for (int e = 0; e < 4; ++e) decr[mt][i][e] = __expf(-0.60653065971f * fsigmoid(az[mt][e][i] + w0v[e])); }
    }
    f32x4 av[2][4];
    for (int rp_ = 0; rp_ < REP_P3; ++rp_) {
        f32x4 aa[2][4], ag[2][4];
#pragma unroll
        for (int mt = 0; mt < 2; ++mt)
#pragma unroll
            for (int nt = 0; nt < 4; ++nt) { aa[mt][nt] = (f32x4){0.f, 0.f, 0.f, 0.f}; ag[mt][nt] = (f32x4){0.f, 0.f, 0.f, 0.f}; }
#pragma unroll
        for (int half = 0; half < 2; ++half) {
            v4u fr[3][4];
#pragma unroll
            for (int k3 = 0; k3 < 3; ++k3)
#pragma unroll
                for (int nt = 0; nt < 4; ++nt) fr[k3][nt] = W.lora[(((3 * half + k3) * 8 + h) * 4 + nt) * 64 + lane];
#pragma unroll
            for (int k3 = 0; k3 < 3; ++k3) {
                const int ks = 3 * half + k3;
                const bf16x8_t af0 = *(const LAS bf16x8_t*)(lds + PR_XA + c * 528 + (64 + 32 * ks + 8 * g) * 2), af1 = *(const LAS bf16x8_t*)(lds + PR_XA + (16 + c) * 528 + (64 + 32 * ks + 8 * g) * 2);
#pragma unroll
                for (int nt = 0; nt < 4; ++nt) {
                    const bf16x8_t bf = __builtin_bit_cast(bf16x8_t, fr[k3][nt]);
                    if (ks < 2) { aa[0][nt] = __builtin_amdgcn_mfma_f32_16x16x32_bf16(af0, bf, aa[0][nt], 0, 0, 0); aa[1][nt] = __builtin_amdgcn_mfma_f32_16x16x32_bf16(af1, bf, aa[1][nt], 0, 0, 0); }
                    else { ag[0][nt] = __builtin_amdgcn_mfma_f32_16x16x32_bf16(af0, bf, ag[0][nt], 0, 0, 0); ag[1][nt] = __builtin_amdgcn_mfma_f32_16x16x32_bf16(af1, bf, ag[1][nt], 0, 0, 0); }
                }
            }
        }
        const f32x4 a0v = *(const f32x4*)(W.a0 + ch);
#pragma unroll
        for (int mt = 0; mt < 2; ++mt)
#pragma unroll
            for (int i = 0; i < 4; ++i) { f32x4 gv;
#pragma unroll
                for (int e = 0; e < 4; ++e) { gv[e] = ag[mt][e][i]; av[mt][i][e] = fsigmoid(aa[mt][e][i] + a0v[e]); }
                *(unsigned long long*)((bf16*)(scanb + 6 * SB) + (size_t)(tok0 + 16 * mt + 4 * g + i) * 512 + ch) = (unsigned long long)cvtpk(gv[0], gv[1]) | ((unsigned long long)cvtpk(gv[2], gv[3]) << 32); }
    }
    asm volatile("" ::: "memory");
    const bf16* rwp = PROJ + (size_t)tok0 * IN_W + OFF_RW + 64 * h + 4 * c;
    const f32x4 mu_r = *(const f32x4*)(W.mu + 64 * h + 4 * c), mu_k = *(const f32x4*)(W.mu + 512 + 64 * h + 4 * c), mu_v = *(const f32x4*)(W.mu + 1024 + 64 * h + 4 * c);
    f32x4 agt[2][4];
    if (layer > 0) {
        LAS unsigned char* vt = lds + PR_VT + wave * 4608;
#pragma unroll
        for (int mt = 0; mt < 2; ++mt) {
            float vv[4][4];
            shifted4(rwp + 1024, 16 * mt + 4 * g, first, mu_v, vv);
#pragma unroll
            for (int i = 0; i < 4; ++i) *(LAS unsigned long long*)(vt + ((16 * mt + 4 * g + i) * 72 + 4 * c) * 2) = (unsigned long long)cvtpk(vv[i][0], vv[i][1]) | ((unsigned long long)cvtpk(vv[i][2], vv[i][3]) << 32);
        }
        f32x4 au[2][2];
#pragma unroll
        for (int mt = 0; mt < 2; ++mt)
#pragma unroll
            for (int n2 = 0; n2 < 2; ++n2) au[mt][n2] = (f32x4){0.f, 0.f, 0.f, 0.f};
        float v1c[2][2][8];
#pragma unroll
        for (int ks = 0; ks < 2; ++ks)
#pragma unroll
            for (int n2 = 0; n2 < 2; ++n2)
#pragma unroll
                for (int jx = 0; jx < 8; ++jx) v1c[ks][n2][jx] = W.v1[(size_t)(64 * h + 32 * ks + 8 * g + jx) * 32 + 16 * n2 + c];
#pragma unroll
        for (int ks = 0; ks < 2; ++ks) {
            const bf16x8_t af0 = *(const LAS bf16x8_t*)(vt + (c * 72 + 32 * ks + 8 * g) * 2), af1 = *(const LAS bf16x8_t*)(vt + ((16 + c) * 72 + 32 * ks + 8 * g) * 2);
#pragma unroll
            for (int n2 = 0; n2 < 2; ++n2) {
                const bf16x8_t bf = pack8(v1c[ks][n2]);
                au[0][n2] = __builtin_amdgcn_mfma_f32_16x16x32_bf16(af0, bf, au[0][n2], 0, 0, 0); au[1][n2] = __builtin_amdgcn_mfma_f32_16x16x32_bf16(af1, bf, au[1][n2], 0, 0, 0);
            }
        }
        LAS float* up = (LAS float*)(lds + PR_UP) + wave * 1056;
#pragma unroll
        for (int mt = 0; mt < 2; ++mt)
#pragma unroll
            for (int n2 = 0; n2 < 2; ++n2)
#pragma unroll
                for (int i = 0; i < 4; ++i) up[(16 * mt + 4 * g + i) * 33 + 16 * n2 + c] = au[mt][n2][i];
        __syncthreads();
#pragma unroll
        for (int o2 = 0; o2 < 2; ++o2) { const int o = tid + 512 * o2, tk = o >> 5, n = o & 31; float sacc = 0.f;
#pragma unroll
            for (int w8 = 0; w8 < 8; ++w8) sacc += ((const LAS float*)(lds + PR_UP))[w8 * 1056 + tk * 33 + n];
            ((LAS float*)(lds + PR_U))[tk * 36 + n] = sacc; }
        __syncthreads();
        f32x4 bw[8];
#pragma unroll
        for (int jx = 0; jx < 8; ++jx) bw[jx] = *(const f32x4*)(W.v2 + (size_t)(8 * g + jx) * 512 + 64 * h + 4 * c);
        bf16x8_t afm[2];
#pragma unroll
        for (int mt = 0; mt < 2; ++mt) { const LAS float* ur = (const LAS float*)(lds + PR_U) + (16 * mt + c) * 36 + 8 * g; float uu[8];
#pragma unroll
            for (int jx = 0; jx < 8; ++jx) uu[jx] = ur[jx];
            afm[mt] = pack8(uu); }
#pragma unroll
        for (int nt = 0; nt < 4; ++nt) {
            const float col[8] = {bw[0][nt], bw[1][nt], bw[2][nt], bw[3][nt], bw[4][nt], bw[5][nt], bw[6][nt], bw[7][nt]};
            const bf16x8_t bf = pack8(col);
            agt[0][nt] = __builtin_amdgcn_mfma_f32_16x16x32_bf16(afm[0], bf, (f32x4){0.f, 0.f, 0.f, 0.f}, 0, 0, 0);
            agt[1][nt] = __builtin_amdgcn_mfma_f32_16x16x32_bf16(afm[1], bf, (f32x4){0.f, 0.f, 0.f, 0.f}, 0, 0, 0);
        }
    }
    __syncthreads();
    LAS unsigned long long* stash_av = (LAS unsigned long long*)(lds + PD_STASH + wave * 4096);
    LAS unsigned long long* stash_gt = (LAS unsigned long long*)(lds + PD_STASH + wave * 4096 + 2048);
#pragma unroll
    for (int i = 0; i < 4; ++i) stash_av[i * 64 + lane] = (unsigned long long)cvtpk(av[1][i][0], av[1][i][1]) | ((unsigned long long)cvtpk(av[1][i][2], av[1][i][3]) << 32);
    if (layer > 0) {
#pragma unroll
        for (int e = 0; e < 4; ++e) stash_gt[e * 64 + lane] = (unsigned long long)cvtpk(agt[1][e][0], agt[1][e][1]) | ((unsigned long long)cvtpk(agt[1][e][2], agt[1][e][3]) << 32); }
    const f32x4 kkv = *(const f32x4*)(W.k_k + ch), kav = *(const f32x4*)(W.k_a + ch), rkv = *(const f32x4*)(W.r_k + ch);
    f32x4 v0v = (f32x4){0.f, 0.f, 0.f, 0.f}; if (layer > 0) v0v = *(const f32x4*)(W.v0 + ch);
    LAS unsigned char* pt = lds + wave * PD_WAVE;
    for (int rp_ = 0; rp_ < REP_P4; ++rp_)
#pragma unroll
    for (int mt = 0; mt < 2; ++mt) {
        asm volatile("" ::: "memory");
        unsigned char* rec = recs + ((size_t)((tok0 + 16 * mt) >> 4) * 8 + h) * RG_BYTES;
        f32x4 avm[4], agm[4];
        if (mt == 0) {
#pragma unroll
            for (int i = 0; i < 4; ++i) { avm[i] = av[0][i]; agm[i] = agt[0][i]; }
        } else {
#pragma unroll
            for (int i = 0; i < 4; ++i) { float t4[4]; unpack4(stash_av[i * 64 + lane], t4); avm[i] = (f32x4){t4[0], t4[1], t4[2], t4[3]};
                if (layer > 0) { unpack4(stash_gt[i * 64 + lane], t4); agm[i] = (f32x4){t4[0], t4[1], t4[2], t4[3]}; } else agm[i] = (f32x4){0.f, 0.f, 0.f, 0.f}; }
        }
        float rr[4][4], kx[4][4], vv[4][4];
        f32x4 gm[4], Eg, Gtot;
        {
#pragma unroll
            for (int i = 0; i < 4; ++i) { const f32x4 d = decr[mt][i];
                gm[i] = (i == 0) ? d : gm[i > 0 ? i - 1 : 0] * d; }
            f32x4 t0, t1, t2, t3;
#pragma unroll
            for (int e = 0; e < 4; ++e) { t0[e] = __shfl(gm[3][e], c); t1[e] = __shfl(gm[3][e], c + 16); t2[e] = __shfl(gm[3][e], c + 32); t3[e] = __shfl(gm[3][e], c + 48); }
            Eg = (g == 0) ? (f32x4){1.f, 1.f, 1.f, 1.f} : (g == 1) ? t0 : (g == 2) ? t0 * t1 : t0 * t1 * t2;
            Gtot = (t0 * t1) * (t2 * t3);
            if (g == 0) { *(f32x4*)(rec + RG_GAM + 16 * c) = Gtot; *(LAS f32x4*)(pt + PD_TG + 16 * c) = Gtot; }
#pragma unroll
            for (int i = 0; i < 4; ++i) gm[i] = gm[i] * Eg;
        }
        asm volatile("" ::: "memory");
        shifted4(rwp, 16 * mt + 4 * g, first, mu_r, rr); shifted4(rwp + 512, 16 * mt + 4 * g, first, mu_k, kx); shifted4(rwp + 1024, 16 * mt + 4 * g, first, mu_v, vv);
        unsigned long long vfw[4] = {0ull, 0ull, 0ull, 0ull};
        if (layer > 0) {
#pragma unroll
            for (int i = 0; i < 4; ++i) vfw[i] = *(const unsigned long long*)((const bf16*)vfirst + (size_t)(tok0 + 16 * mt + 4 * g + i) * 512 + ch);
        }
#pragma unroll
        for (int i = 0; i < 4; ++i) {
            const size_t o = (size_t)(tok0 + 16 * mt + 4 * g + i) * 512 + ch;
            f32x4 vo, kkq, kmq, ro;
            float ssq = 0.f, bsum = 0.f;
#pragma unroll
            for (int e = 0; e < 4; ++e) {
                ro[e] = rr[i][e];
                kkq[e] = kx[i][e] * kkv[e]; ssq += kkq[e] * kkq[e];
                kmq[e] = kx[i][e] * (1.f + (avm[i][e] - 1.f) * kav[e]);
                bsum += rr[i][e] * kmq[e] * rkv[e];
            }
            if (layer > 0) { float vf[4]; unpack4(vfw[i], vf);
#pragma unroll
                for (int e = 0; e < 4; ++e) vo[e] = vv[i][e] + (vf[e] - vv[i][e]) * fsigmoid(v0v[e] + agm[e][i]); }
            else { vo = (f32x4){vv[i][0], vv[i][1], vv[i][2], vv[i][3]}; *(unsigned long long*)((bf16*)vfirst + o) = (unsigned long long)cvtpk(vo[0], vo[1]) | ((unsigned long long)cvtpk(vo[2], vo[3]) << 32); }
            ssq = allreduce16(ssq); bsum = allreduce16(bsum);
            const float rn = rsqrtf(fmaxf(ssq, 1e-24f));
            f32x4 an, bn;
#pragma unroll
            for (int e = 0; e < 4; ++e) { const float kn = kkq[e] * rn; an[e] = -kn; bn[e] = kn * avm[i][e]; }
            if (c == 0) *(f32x4*)(sc2 + ((size_t)(tok0 + 16 * mt + 4 * g + i) * 8 + h) * 4) = (f32x4){0.f, 0.f, bsum, 0.f};
            const f32x4 gam = gm[i], gamp = (i == 0) ? Eg : gm[i > 0 ? i - 1 : 0];
            const f32x4 ginv = (f32x4){__builtin_amdgcn_rcpf(gam[0]), __builtin_amdgcn_rcpf(gam[1]), __builtin_amdgcn_rcpf(gam[2]), __builtin_amdgcn_rcpf(gam[3])};
            const f32x4 rt = ro * gam, at = an * gamp, bt = bn * ginv, kt = kmq * ginv;
#define PK4(val) ((unsigned long long)cvtpk((val)[0], (val)[1]) | ((unsigned long long)cvtpk((val)[2], (val)[3]) << 32))
            const unsigned long long pa = PK4(at), pr = PK4(rt), pb = PK4(bt), pk = PK4(kt), pv = PK4(vo);
#undef PK4
            const int trow = (4 * g + i) * 144 + 8 * c;
            const int grow = (4 * g + i) * 128 + 8 * c;
            *(unsigned long long*)(rec + RG_AT + grow) = pa; *(unsigned long long*)(rec + RG_RT + grow) = pr;
            *(LAS unsigned long long*)(pt + PD_TA + trow) = pa; *(LAS unsigned long long*)(pt + PD_TR + trow) = pr; *(LAS unsigned long long*)(pt + PD_TB + trow) = pb;
            *(LAS unsigned long long*)(pt + PD_TK + trow) = pk; *(LAS unsigned long long*)(pt + PD_TV + trow) = pv;
            *(unsigned long long*)((bf16*)(scanb + 5 * SB) + o) = pv;
        }
        {
            f32x4 nN = (f32x4){0.f, 0.f, 0.f, 0.f}, nM = nN, nG1 = nN, nG2 = nN;
#pragma unroll
            for (int ks = 0; ks < 2; ++ks) { const int fo = c * 144 + ks * 64 + g * 16;
                const bf16x8_t fB = *(const LAS bf16x8_t*)(pt + PD_TB + fo), fK = *(const LAS bf16x8_t*)(pt + PD_TK + fo), fA = *(const LAS bf16x8_t*)(pt + PD_TA + fo), fR = *(const LAS bf16x8_t*)(pt + PD_TR + fo);
                nN = __builtin_amdgcn_mfma_f32_16x16x32_bf16(fB, fA, nN, 0, 0, 0); nM = __builtin_amdgcn_mfma_f32_16x16x32_bf16(fK, fA, nM, 0, 0, 0);
                nG1 = __builtin_amdgcn_mfma_f32_16x16x32_bf16(fB, fR, nG1, 0, 0, 0); nG2 = __builtin_amdgcn_mfma_f32_16x16x32_bf16(fK, fR, nG2, 0, 0, 0); }
#pragma unroll
            for (int i = 0; i < 4; ++i) { const int j = 4 * g + i; if (j >= c) { nN[i] = 0.f; nM[i] = 0.f; } if (j > c) { nG1[i] = 0.f; nG2[i] = 0.f; } }
            LAS float* nt = (LAS float*)(pt + PD_NT);
            *(LAS f32x4*)(nt + c * 16 + 4 * g) = nN;
            {
                float tr[16];
#pragma unroll
                for (int t = 0; t < 16; ++t) tr[t] = (t == c) ? 1.f : 0.f;
#pragma unroll
                for (int t = 1; t < 16; ++t) {
#pragma unroll
                    for (int jb = 0; jb * 4 < t; ++jb) { const f32x4 n4 = *(const LAS f32x4*)(nt + t * 16 + jb * 4);
                        tr[t] = fmaf(tr[4 * jb], n4[0], tr[t]); if (4 * jb + 1 < t) tr[t] = fmaf(tr[4 * jb + 1], n4[1], tr[t]); if (4 * jb + 2 < t) tr[t] = fmaf(tr[4 * jb + 2], n4[2], tr[t]); if (4 * jb + 3 < t) tr[t] = fmaf(tr[4 * jb + 3], n4[3], tr[t]); }
                }
                if (g == 0) {
#pragma unroll
                    for (int t = 0; t < 16; ++t) *(float*)(rec + RG_NT + t * 64 + c * 4) = tr[t];
                }
            }
            *(unsigned long long*)(rec + RG_MT + c * 32 + g * 8) = (unsigned long long)cvtpk(nM[0], nM[1]) | ((unsigned long long)cvtpk(nM[2], nM[3]) << 32);
            *(unsigned long long*)(rec + RG_GT + c * 64 + g * 8) = (unsigned long long)cvtpk(nG1[0], nG1[1]) | ((unsigned long long)cvtpk(nG1[2], nG1[3]) << 32);
            *(unsigned long long*)(rec + RG_GT + c * 64 + 32 + g * 8) = (unsigned long long)cvtpk(nG2[0], nG2[1]) | ((unsigned long long)cvtpk(nG2[2], nG2[3]) << 32);
        }
        {
            const int tro = (4 * g + (c >> 2)) * 144 + (c & 3) * 8;
#pragma unroll
            for (int m = 0; m < 4; ++m) {
                const float gch = *(const LAS float*)(pt + PD_TG + (16 * m + c) * 4);
                const unsigned long long tb = __builtin_bit_cast(unsigned long long, __builtin_amdgcn_ds_read_tr16_b64_v4i16((LAS s16x4_t*)(pt + PD_TB + tro + m * 32)));
                const unsigned long long tk = __builtin_bit_cast(unsigned long long, __builtin_amdgcn_ds_read_tr16_b64_v4i16((LAS s16x4_t*)(pt + PD_TK + tro + m * 32)));
                const unsigned long long tv = __builtin_bit_cast(unsigned long long, __builtin_amdgcn_ds_read_tr16_b64_v4i16((LAS s16x4_t*)(pt + PD_TV + tro + m * 32)));
                float fb[4], fk[4]; unpack4(tb, fb); unpack4(tk, fk);
                unsigned char* brow = rec + RG_BKT + (16 * m + c) * 64 + g * 8;
                *(unsigned long long*)brow = (unsigned long long)cvtpk(fb[0] * gch, fb[1] * gch) | ((unsigned long long)cvtpk(fb[2] * gch, fb[3] * gch) << 32);
                *(unsigned long long*)(brow + 32) = (unsigned long long)cvtpk(fk[0] * gch, fk[1] * gch) | ((unsigned long long)cvtpk(fk[2] * gch, fk[3] * gch) << 32);
                *(unsigned long long*)(rec + RG_VT + (16 * m + c) * 32 + g * 8) = tv;
            }
        }
    }
    __syncthreads();
}

typedef GAS unsigned gu32;
#define RLX_AGENT __ATOMIC_RELAXED, __HIP_MEMORY_SCOPE_AGENT
#define XB_TMO      128
#define XB_XCNT(j)  (256  + 64 * (j))
#define XB_XSUB(j)  (1280 + 64 * (j))
#define XB_XGEN(j)  (2304 + 64 * (j))
#define XB_TOP      3328
#define XB_TOPGEN   3392
#define XCD_BAR_WORDS 3456
#define XB_SPIN_CAP (1u << 18)

__device__ __forceinline__ unsigned xb_ld(unsigned* p)              { return __hip_atomic_load(p, __ATOMIC_RELAXED, __HIP_MEMORY_SCOPE_AGENT); }
__device__ __forceinline__ unsigned xb_add(unsigned* p, unsigned v) { return __hip_atomic_fetch_add(p, v, __ATOMIC_RELAXED, __HIP_MEMORY_SCOPE_AGENT); }
__device__ __forceinline__ unsigned xb_xcc_id() { return (unsigned)__builtin_amdgcn_s_getreg((3 << 11) | 20) & 0xFu; }
#define XB_SPIN(cond, bar) do { unsigned _sp = 0; while (cond) { __builtin_amdgcn_s_sleep(1); \
    if ((++_sp & 255u) == 0u) { if (xb_ld(&(bar)[XB_TMO])) break; if (_sp > XB_SPIN_CAP) { atomicAdd(&(bar)[XB_TMO], 1u); break; } } } } while (0)

struct XcdBarrier {
    unsigned* bar; unsigned x;
    volatile LAS unsigned* st;
};

__device__ __forceinline__ XcdBarrier xcd_barrier_post(unsigned* bar, volatile LAS unsigned* st) {
    XcdBarrier b; b.bar = bar; b.x = xb_xcc_id(); b.st = st;
    if (threadIdx.x == 0) (void)xb_add(&bar[XB_XCNT(b.x)], 1u);
    return b;
}
__device__ __forceinline__ void xcd_barrier_complete(unsigned* bar, unsigned x, unsigned& nloc, unsigned& nx) {
    const unsigned G = gridDim.x * gridDim.y * gridDim.z;
    unsigned sum, cnt, mine, sp = 0u;
    for (;;) {
        sum = 0u; cnt = 0u; mine = 0u;
#pragma unroll
        for (unsigned j = 0; j < 16; ++j) { const unsigned c = xb_ld(&bar[XB_XCNT(j)]); sum += c; cnt += (c > 0u) ? 1u : 0u; mine = (j == x) ? c : mine; }
        if (sum == G) break;
        __builtin_amdgcn_s_sleep(1);
        if ((++sp & 255u) == 0u) { if (xb_ld(&bar[XB_TMO])) break; if (sp > XB_SPIN_CAP) { atomicAdd(&bar[XB_TMO], 1u); break; } }
    }
    nloc = mine > 0u ? mine : 1u; nx = cnt > 0u ? cnt : 1u;
}

__device__ __forceinline__ void xcd_barrier(const XcdBarrier& b) {
    asm volatile("s_waitcnt vmcnt(0)" ::: "memory");
    __syncthreads();
    if (threadIdx.x == 0) {
        unsigned* bar = b.bar;
        __builtin_amdgcn_s_waitcnt(0);
        unsigned nloc = b.st[0], nx = b.st[1];
        if (nloc == 0u) { xcd_barrier_complete(bar, b.x, nloc, nx); b.st[0] = nloc; b.st[1] = nx; }
        const unsigned old = xb_add(&bar[XB_XSUB(b.x)], 1u);
        const unsigned gen = old / nloc;
        if (old + 1u == (gen + 1u) * nloc) {
            __builtin_amdgcn_fence(__ATOMIC_RELEASE, "agent");
            asm volatile("s_waitcnt vmcnt(0)" ::: "memory");
            const unsigned og = xb_add(&bar[XB_TOP], 1u);
            const unsigned tg = og / nx;
            if (og + 1u == (tg + 1u) * nx) xb_add(&bar[XB_TOPGEN], 1u);
            else XB_SPIN(xb_ld(&bar[XB_TOPGEN]) == tg, bar);
            __builtin_amdgcn_fence(__ATOMIC_ACQUIRE, "agent");
            xb_add(&bar[XB_XGEN(b.x)], 1u);
            asm volatile("s_waitcnt vmcnt(0)" ::: "memory");
        } else {
            XB_SPIN(xb_ld(&bar[XB_XGEN(b.x)]) == gen, bar);
            __builtin_amdgcn_fence(__ATOMIC_ACQUIRE, "agent");
            asm volatile("s_waitcnt vmcnt(0)" ::: "memory");
        }
    }
    __syncthreads();
}


#define XB_EXIT 3520
__device__ unsigned g_bar[4096];

constexpr int NWAVES = 8;
constexpr size_t MiB = 1u << 20;
constexpr size_t WS_CTL = 0;
constexpr size_t WS_WT = 2 * MiB;
constexpr size_t WT_LAYER = 94 * MiB, WT_IN = 0, WT_OUT = 22 * MiB, WT_UP = 30 * MiB, WT_DOWN = 62 * MiB;
constexpr size_t WS_HN = 192 * MiB;
constexpr size_t WS_VFIRST = 224 * MiB;
constexpr size_t WS_PROJ = 240 * MiB;
constexpr size_t WS_MIX = 328 * MiB;
constexpr size_t WS_SCAN = 360 * MiB;
constexpr size_t WS_H = 240 * MiB;
constexpr size_t OUT_DILO = 0, OUT_DILL = 24 * MiB, OUT_SC2 = 25 * MiB;
constexpr size_t WS_SSPF = 190 * MiB;
constexpr size_t WS_LORA = 191 * MiB;
constexpr size_t WS_SSP = 1 * MiB;
constexpr size_t WS_END = 504 * MiB;
constexpr int N_SCAN_WG = BATCH * 8;
constexpr int LDS_BYTES = 163840;

struct Params { const float* in[28]; float* out; unsigned char* ws; int ph_lo, ph_hi; };

__device__ __forceinline__ void transpose_item(const float* W, int K, int N, bf16* WT, LAS float* scr, int item, int lane) {
    const int nblk = N / 32, kb = item / nblk, nb = item % nblk, k0 = 64 * kb, n0 = 32 * nb;
    const int kr = lane >> 3, nq = lane & 7;
    f32x4 v[8];
#pragma unroll
    for (int i = 0; i < 8; ++i) v[i] = __builtin_nontemporal_load((const f32x4*)(W + (size_t)(k0 + 8 * i + kr) * N + n0 + 4 * nq));
#pragma unroll
    for (int i = 0; i < 8; ++i) { LAS float* d = scr + (8 * i + kr) * 33 + 4 * nq; d[0] = v[i].x; d[1] = v[i].y; d[2] = v[i].z; d[3] = v[i].w; }
    asm volatile("s_waitcnt lgkmcnt(0)" ::: "memory");
    const int c = lane & 7;
#pragma unroll
    for (int j = 0; j < 4; ++j) { const int n = (lane >> 3) + 8 * j; const LAS float* s = scr + (8 * c) * 33 + n;
        v4u o; o.x = pk2(s[0 * 33], s[1 * 33]); o.y = pk2(s[2 * 33], s[3 * 33]); o.z = pk2(s[4 * 33], s[5 * 33]); o.w = pk2(s[6 * 33], s[7 * 33]);
        *(v4u*)(WT + (size_t)(n0 + n) * K + k0 + 8 * c) = o; }
    asm volatile("s_waitcnt lgkmcnt(0)" ::: "memory");
}
__device__ __forceinline__ void row_to_bf16_ssq(const float* xrow, const float* g, bf16* orow, float* ssprow, int lane) {
    const f32x4* xr = (const f32x4*)xrow + lane; const f32x4* gr = (const f32x4*)g + lane;
    f32x4 v[8]; float s = 0.f;
#pragma unroll
    for (int j = 0; j < 8; ++j) { v[j] = xr[64 * j]; s += (v[j].x * v[j].x + v[j].y * v[j].y) + (v[j].z * v[j].z + v[j].w * v[j].w); }
    s = wave_sum(s);
    if (lane < 32) ssprow[lane] = (lane == 0) ? s : 0.f;
    unsigned long long* o8 = (unsigned long long*)orow + lane;
#pragma unroll
    for (int j = 0; j < 8; ++j) { const f32x4 gg = gr[64 * j]; o8[64 * j] = (unsigned long long)pk2(v[j].x * gg.x, v[j].y * gg.y) | ((unsigned long long)pk2(v[j].z * gg.z, v[j].w * gg.w) << 32); }
}

__device__ __forceinline__ void conv_job(const Params& p, unsigned char* ws, int l, int i0, int i1, int wv, int nw, LAS float* scr, int lane) {
    unsigned char* wtl = ws + WS_WT + l * WT_LAYER;
    constexpr int I_OUT = (D_MODEL / 64) * (D_MODEL / 32), I_UP = (D_MODEL / 64) * (D_FF / 32), I_DOWN = (D_FF / 64) * (D_MODEL / 32);
    for (int it = i0 + wv; it < i1; it += nw) {
        int r = it;
        if (r >= I_OUT + I_UP + I_DOWN) { transpose_item(p.in[2] + (size_t)(l + 1) * D_MODEL * IN_W, D_MODEL, IN_W, (bf16*)(ws + WS_WT + (l + 1) * WT_LAYER + WT_IN), scr, r - (I_OUT + I_UP + I_DOWN), lane); continue; }
        if (r < I_OUT) { transpose_item(p.in[23] + (size_t)l * D_MODEL * D_MODEL, D_MODEL, D_MODEL, (bf16*)(wtl + WT_OUT), scr, r, lane); continue; } r -= I_OUT;
        if (r < I_UP) { transpose_item(p.in[25] + (size_t)l * D_MODEL * D_FF, D_MODEL, D_FF, (bf16*)(wtl + WT_UP), scr, r, lane); continue; } r -= I_UP;
        transpose_item(p.in[26] + (size_t)l * D_FF * D_MODEL, D_FF, D_MODEL, (bf16*)(wtl + WT_DOWN), scr, r, lane);
    }
}
constexpr int CJ_TOTAL = (D_MODEL / 64) * (D_MODEL / 32) + (D_MODEL / 64) * (D_FF / 32) + (D_FF / 64) * (D_MODEL / 32);
#ifndef CJ_EARLY
#define CJ_EARLY 8192
#endif
constexpr int GIN_FULL = (M_TOK / 256) * (IN_W / 256) - 2 * 256;

#ifndef DUP_SUB
#define DUP_SUB (-1)
#endif
#ifndef REP_SCAN
#define REP_SCAN 1
#endif
#ifndef REP_ATT
#define REP_ATT 1
#define STAGGER_UP 0
#endif
#ifndef DUP0
#define DUP0 0
#endif
constexpr int PH_PER_LAYER = 7, SLOTS = PH_PER_LAYER + (DUP_SUB >= 0 ? 1 : 0), N_PHASES = 1 + DUP0 + SLOTS * DEPTH;

__global__ void __launch_bounds__(NWAVES * 64, 2) mk_fwd(Params p) {
    extern __shared__ __attribute__((aligned(16))) unsigned char lds_raw[];
    LAS unsigned char* lds = (LAS unsigned char*)lds_raw;
    const int wave = __builtin_amdgcn_readfirstlane((int)threadIdx.x >> 6);
    const int G = gridDim.x, bx = blockIdx.x;
    const int gw = bx * NWAVES + wave, NGW = G * NWAVES;
    unsigned char* ws = p.ws;
    bf16* HN = (bf16*)(ws + WS_HN); bf16* PROJ = (bf16*)(ws + WS_PROJ); bf16* MIX = (bf16*)(ws + WS_MIX); bf16* HB = (bf16*)(ws + WS_H); float* SSP = (float*)(ws + WS_SSP); float* SSPF = (float*)(ws + WS_SSPF);
    volatile LAS unsigned* bst = (volatile LAS unsigned*)(lds + LDS_BYTES - 64);
    if (threadIdx.x < 16) bst[threadIdx.x] = 0u;
    __syncthreads();
    XcdBarrier xbar = xcd_barrier_post(g_bar, bst);
    for (int ph = p.ph_lo; ph < p.ph_hi; ++ph) {
        if (ph > p.ph_lo) xcd_barrier(xbar);
        int tid = threadIdx.x; asm volatile("" : "+v"(tid));
        const int lane = tid & 63;
        if (ph <= DUP0) {
            LAS float* scr = (LAS float*)(lds + wave * 16384);
            constexpr int I_IN = (D_MODEL / 64) * (IN_W / 32);
            for (int it = gw; it < I_IN; it += NGW) transpose_item(p.in[2], D_MODEL, IN_W, (bf16*)(ws + WS_WT + WT_IN), scr, it, lane);
            {
                v4u* FR = (v4u*)(ws + WS_LORA);
                for (int idx = (int)blockIdx.x * (NWAVES * 64) + tid; idx < DEPTH * 6 * 8 * 4 * 64; idx += (int)gridDim.x * (NWAVES * 64)) {
                    const int ln = idx & 63, nt = (idx >> 6) & 3, hh = (idx >> 8) & 7, ks = (idx >> 11) % 6, ll = (idx >> 11) / 6, gg = ln >> 4, cc = ln & 15;
                    const float* Wt = (ks < 2) ? p.in[13] + (size_t)ll * 64 * 512 + (size_t)(32 * ks + 8 * gg) * 512 : p.in[14] + (size_t)ll * 128 * 512 + (size_t)(32 * (ks - 2) + 8 * gg) * 512;
                    float col[8];
#pragma unroll
                    for (int jx = 0; jx < 8; ++jx) col[jx] = Wt[(size_t)jx * 512 + 64 * hh + 4 * cc + nt];
                    FR[idx] = __builtin_bit_cast(v4u, pack8(col));
                }
            }
            for (int m = gw; m < M_TOK; m += NGW) row_to_bf16_ssq(p.in[0] + (size_t)m * D_MODEL, p.in[1], HN + (size_t)m * D_MODEL, SSP + (size_t)m * 32, lane);
            continue;
        }
        const int l = (ph - 1 - DUP0) / SLOTS, slot = (ph - 1 - DUP0) % SLOTS, sub = (DUP_SUB >= 0 && slot > DUP_SUB) ? slot - 1 : slot;
        const unsigned char* wt = ws + WS_WT + l * WT_LAYER;
        if (sub == 0) {
            for (int st_ = 0; st_ < ((bx >> 3) & 3) * STAGGER_UP; ++st_) __builtin_amdgcn_s_sleep(8);
            pg8::Gemm g{HN, (const bf16*)(wt + WT_IN), M_TOK, IN_W, D_MODEL}; pg8::StaticOrder S; S.init(M_TOK, IN_W, G, bx);
            pg8::EpiBf16<0> E{PROJ, IN_W, SSP};
            {
                pg8::Unit u0;
                if (S.next(0, u0)) {
                    LAS float* rsl = (LAS float*)(lds + pg8::STAGE_BYTES);
                    const int r = tid >> 1, hh = tid & 1; const f32x4* sp = (const f32x4*)(SSP + (size_t)(u0.pm * 256 + r) * 32 + 16 * hh);
                    const f32x4 a = sp[0], b = sp[1], c4 = sp[2], d = sp[3];
                    float t = (((a[0] + a[1]) + (a[2] + a[3])) + ((b[0] + b[1]) + (b[2] + b[3]))) + (((c4[0] + c4[1]) + (c4[2] + c4[3])) + ((d[0] + d[1]) + (d[2] + d[3])));
                    t += __shfl_xor(t, 1);
                    if (hh == 0) rsl[r] = __builtin_amdgcn_rsqf(t * (1.f / 2048.f) + 1e-6f);
                    __syncthreads();
                    E.rs_lds = rsl; E.rs_pm = u0.pm;
                }
            }
            pg8::gemm_phase<pg8::EpiBf16<0>, pg8::StaticOrder, true, true>(lds, g, S, E);
            if (G == 256 && bx >= GIN_FULL) conv_job(p, ws, l, 0, CJ_EARLY, (bx - GIN_FULL) * NWAVES + wave, (G - GIN_FULL) * NWAVES, (LAS float*)(lds + wave * 16384), lane);
        } else if (sub == 4) {
            pg8::Gemm g{MIX, (const bf16*)(wt + WT_OUT), M_TOK, D_MODEL, D_MODEL}; pg8::StaticOrder S; S.init(M_TOK, D_MODEL, G, bx);
            if (l == 0) { pg8::EpiRes<0, false, true, false> E{nullptr, p.in[0], D_MODEL, HN, p.in[24], SSPF, nullptr, nullptr};
                pg8::gemm_phase<pg8::EpiRes<0, false, true, false>, pg8::StaticOrder, true, true>(lds, g, S, E); }
            else { pg8::EpiRes<1, false, true, false> E{nullptr, nullptr, D_MODEL, HN, p.in[24] + l * D_MODEL, SSPF, nullptr, p.in[1] + l * D_MODEL};
                pg8::gemm_phase<pg8::EpiRes<1, false, true, false>, pg8::StaticOrder, true, true>(lds, g, S, E); }
        } else if (sub == 5) {
            for (int st_ = 0; st_ < ((bx >> 3) & 3) * STAGGER_UP; ++st_) __builtin_amdgcn_s_sleep(8);
            pg8::Gemm g{HN, (const bf16*)(wt + WT_UP), M_TOK, D_FF, D_MODEL}; pg8::StaticOrder S; S.init(M_TOK, D_FF, G, bx);
            pg8::EpiBf16<1, false> E{HB, D_FF, nullptr};
            pg8::gemm_phase<pg8::EpiBf16<1, false>, pg8::StaticOrder, true, true>(lds, g, S, E);
        } else if (sub == 6) {
            pg8::Gemm g{HB, (const bf16*)(wt + WT_DOWN), M_TOK, D_MODEL, D_FF}; pg8::StaticOrder S; S.init(M_TOK, D_MODEL, G, bx);
            if (l + 1 < DEPTH) { pg8::EpiRes<1, false, true, true> E{nullptr, nullptr, D_MODEL, HN, p.in[1] + (l + 1) * D_MODEL, SSP, SSPF, p.in[24] + l * D_MODEL};
                pg8::gemm_phase<pg8::EpiRes<1, false, true, true>, pg8::StaticOrder, true, true>(lds, g, S, E); }
            else { pg8::EpiRes<1, true, false, true> E{p.out, nullptr, D_MODEL, HN, nullptr, nullptr, SSPF, p.in[24] + l * D_MODEL};
                pg8::gemm_phase<pg8::EpiRes<1, true, false, true>, pg8::StaticOrder, true, true>(lds, g, S, E); }
        }
        else if (sub == 1) {
            RwkvP W;
            W.mu = p.in[9] + l * RW_W; W.w0 = p.in[10] + l * 512; W.w2 = p.in[11] + (size_t)l * 64 * 512; W.a0 = p.in[12] + l * 512; W.a2 = p.in[13] + (size_t)l * 64 * 512;
            W.g2 = p.in[14] + (size_t)l * 128 * 512; W.k_k = p.in[15] + l * 512; W.k_a = p.in[16] + l * 512; W.r_k = p.in[17] + l * 512;
            W.v0 = p.in[20]; W.v1 = p.in[21]; W.v2 = p.in[22]; W.lora = (const v4u*)(ws + WS_LORA) + (size_t)l * 6 * 2048;
            for (int tt = bx; tt < M_TOK / 32; tt += G) prep_tile(lds, tt, tid, PROJ, p.in[3] + l * 3 * 512, W, l, (float*)(ws + WS_SCAN), (float*)((unsigned char*)p.out + OUT_SC2), (float*)(ws + WS_VFIRST), MIX);
        }
        else if (sub == 2) {
            float* scanb = (float*)(ws + WS_SCAN); const size_t SB = (size_t)M_TOK * 512;
            if (bx < N_SCAN_WG) for (int rep_ = 0; rep_ < REP_SCAN; ++rep_) chain_wg(lds, bx, (const unsigned char*)scanb, scanb + 8 * SB, tid);
            else for (int pass = 0; pass < 2; ++pass) {
                if ((((bx - N_SCAN_WG) ^ pass) & 1) == 0) {
                    for (int rep_ = 0; rep_ < REP_ATT; ++rep_) attn_wg(lds, bx - N_SCAN_WG, G - N_SCAN_WG, (G - N_SCAN_WG) % 8 == 0, PROJ, p.in[4] + l * 64, p.in[5] + l * 64, p.in[6] + l * 8, p.in[7] + l * 64, p.in[8] + l * 64, p.in[27], MIX, (bf16*)((unsigned char*)p.out + OUT_DILO), (float*)((unsigned char*)p.out + OUT_DILL), (float*)((unsigned char*)p.out + OUT_SC2), tid);
                    __syncthreads();
                } else {
                    conv_job(p, ws, l, (G == 256) ? CJ_EARLY : 0, CJ_TOTAL + ((l + 1 < DEPTH) ? (D_MODEL / 64) * (IN_W / 32) : 0), (bx - N_SCAN_WG) * NWAVES + wave, (G - N_SCAN_WG) * NWAVES, (LAS float*)(lds + wave * 16384), lane);
                    __syncthreads();
                }
            }
        } else if (sub == 3) {
            float* scanb = (float*)(ws + WS_SCAN); const size_t SB = (size_t)M_TOK * 512;
            for (int m = gw; m < M_TOK; m += NGW) post_token((size_t)m, lane, scanb + 8 * SB, (const bf16*)(scanb + 6 * SB), (const bf16*)(scanb + 5 * SB), (const float*)((unsigned char*)p.out + OUT_SC2), p.in[18] + l * 512, p.in[19] + l * 512, (const bf16*)((unsigned char*)p.out + OUT_DILO), (const float*)((unsigned char*)p.out + OUT_DILL), MIX);
        }
    }
    if (p.ph_hi - p.ph_lo > 1) {
        __syncthreads();
        if (threadIdx.x == 0) bst[4] = (xb_add(&g_bar[XB_EXIT], 1u) == gridDim.x - 1u) ? 1u : 0u;
        __syncthreads();
        if (bst[4] != 0u) { for (int i = threadIdx.x; i < 4096; i += NWAVES * 64) __hip_atomic_store(&g_bar[i], 0u, __ATOMIC_RELAXED, __HIP_MEMORY_SCOPE_AGENT); }
    }
}

static void launch_range(const Params& base, int lo, int hi, int grid, hipStream_t stream) {
    Params p = base; p.ph_lo = lo; p.ph_hi = hi;
    if (hi - lo > 1) { void* args[] = {&p}; hipError_t e = hipLaunchCooperativeKernel((void*)mk_fwd, dim3(grid), dim3(NWAVES * 64), args, LDS_BYTES, stream);
        if (e != hipSuccess) fprintf(stderr, "cooperative launch failed: %s (grid %d)\n", hipGetErrorString(e), grid); }
    else hipLaunchKernelGGL(mk_fwd, dim3(grid), dim3(NWAVES * 64), LDS_BYTES, stream, p);
}
extern "C" void kernel_launch(void* const* d_in, const int* in_sizes, int n_in, void* d_out, int out_size, void* d_ws, size_t ws_size, hipStream_t stream) {
    static int grid = 0;
    if (grid == 0) {
        if (ws_size < WS_END || n_in != 28 || out_size != M_TOK * D_MODEL) { fprintf(stderr, "kernel_launch: unexpected sizes (ws %zu)\n", ws_size); grid = -1; return; }
        int dev = 0, cus = 0, per_cu = 0;
        hipGetDevice(&dev); hipDeviceGetAttribute(&cus, hipDeviceAttributeMultiprocessorCount, dev);
        hipFuncSetAttribute((const void*)mk_fwd, hipFuncAttributeMaxDynamicSharedMemorySize, LDS_BYTES);
        hipOccupancyMaxActiveBlocksPerMultiprocessor(&per_cu, (const void*)mk_fwd, NWAVES * 64, LDS_BYTES);
        if (per_cu < 1) { fprintf(stderr, "kernel_launch: occupancy query says %d blocks per CU\n", per_cu); grid = -1; return; }
        grid = cus;
    }
    if (grid < 0) return;
    Params P{};
    for (int i = 0; i < 28; ++i) P.in[i] = (const float*)d_in[i];
    P.out = (float*)d_out; P.ws = (unsigned char*)d_ws;
    launch_range(P, 0, N_PHASES, grid, stream);
}
```
